# Optimizing an MI355X kernel written in HIP

```python
import jax, jax.numpy as jnp
from jax import lax
import numpy as np

D_MODEL = 1024
BATCH = 8
SEQ = 2048
DEPTH = 1

MIX_WIDTH = D_MODEL
MLSTM_HEADS = 4
MLSTM_WIDTH = MIX_WIDTH // 2
MLSTM_HEAD_DIM = MLSTM_WIDTH // MLSTM_HEADS
MLSTM_CHUNK = 64
CONV_WIDTH = 4
GLA_HEADS = 4
GLA_WIDTH = MIX_WIDTH - MLSTM_WIDTH
GLA_DV = GLA_WIDTH // GLA_HEADS
GLA_DK = GLA_DV // 2
GLA_GATE_RANK = 16
GLA_TAU = 16.0
GLA_CHUNK = 64
IN_SPLITS = (
    MLSTM_WIDTH, MLSTM_WIDTH, MLSTM_WIDTH, MLSTM_WIDTH,
    MLSTM_HEADS, MLSTM_HEADS,
    GLA_HEADS * GLA_DK, GLA_HEADS * GLA_DK,
    GLA_WIDTH, GLA_WIDTH,
    GLA_GATE_RANK,
)
IN_WIDTH = sum(IN_SPLITS)
N_GROUPS = 4
EXPERTS_PER_GROUP = 8
N_EXPERTS = N_GROUPS * EXPERTS_PER_GROUP
TOP_K_IN_GROUP = 2
D_EXPERT = D_MODEL // 2
DEEPNORM_ALPHA = (2 * DEPTH) ** 0.25
DEEPNORM_BETA = (8 * DEPTH) ** -0.25
LN_EPS = 1e-5

kernel_name = 'hybrid_mlstm_gla_hmoe_deepnorm_adaln'


def layer_norm(x, g, b):
    xf = x.astype(jnp.float32)
    mu = jnp.mean(xf, -1, keepdims=True)
    var = jnp.mean(jnp.square(xf - mu), -1, keepdims=True)
    return ((xf - mu) * lax.rsqrt(var + LN_EPS)).astype(x.dtype) * g + b


def head_rms_norm(h, g):
    B, S, H, d = h.shape
    hn = h * lax.rsqrt(jnp.mean(jnp.square(h), -1, keepdims=True) + LN_EPS)
    return hn.reshape(B, S, H * d).astype(g.dtype) * g


def causal_depthwise_conv(u, w, b):
    ch = u.shape[-1]
    out = lax.conv_general_dilated(
        u, w[:, None, :], window_strides=(1,), padding=[(w.shape[0] - 1, 0)],
        dimension_numbers=('NWC', 'WIO', 'NWC'), feature_group_count=ch)
    return out + b


def to_chunks(t, L):
    B, S = t.shape[:2]
    t = t.reshape((B, S // L, L) + t.shape[2:])
    perm = (1, 0, 3, 2) + tuple(range(4, t.ndim))
    return t.transpose(perm)


def from_chunks(h):
    NC, B, H, L, d = h.shape
    return h.transpose(1, 0, 3, 2, 4).reshape(B, NC * L, H, d)


def mlstm_chunkwise(q, k, v, ig, lf):
    B, S, H, d = q.shape
    L = MLSTM_CHUNK
    xs = tuple(to_chunks(t, L) for t in (q, k, v, ig, lf))
    mask = jnp.tril(jnp.ones((L, L), dtype=bool))
    init = (jnp.zeros((B, H, d, d), jnp.float32),
            jnp.zeros((B, H, d), jnp.float32),
            jnp.zeros((B, H), jnp.float32))

    def step(carry, inp):
        C, n, m = carry
        qc, kc, vc, ic, fc = inp
        b = jnp.cumsum(fc, axis=-1)
        dmat = jnp.where(mask, b[..., :, None] - b[..., None, :] + ic[..., None, :], -jnp.inf)
        m_inter = b + m[..., None]
        m_t = jnp.maximum(jnp.max(dmat, -1), m_inter)
        scores = jnp.einsum('bhtd,bhsd->bhts', qc, kc) * jnp.exp(dmat - m_t[..., None])
        inter = jnp.exp(m_inter - m_t)
        num = (jnp.einsum('bhts,bhsv->bhtv', scores, vc)
               + inter[..., None] * jnp.einsum('bhtk,bhkv->bhtv', qc, C))
        den = jnp.sum(scores, -1) + inter * jnp.einsum('bhtk,bhk->bht', qc, n)
        h = num / jnp.maximum(jnp.abs(den), jnp.exp(-m_t))[..., None]
        bL = b[..., -1]
        w_log = bL[..., None] - b + ic
        m_new = jnp.maximum(bL + m, jnp.max(w_log, -1))
        decay = jnp.exp(bL + m - m_new)
        ws = jnp.exp(w_log - m_new[..., None])
        C_new = decay[..., None, None] * C + jnp.einsum('bhs,bhsk,bhsv->bhkv', ws, kc, vc)
        n_new = decay[..., None] * n + jnp.einsum('bhs,bhsk->bhk', ws, kc)
        return (C_new, n_new, m_new), h

    _, h = lax.scan(step, init, xs)
    return from_chunks(h)


def gla_chunked(q, k, v, log_a):
    B, S, H, dk = q.shape
    dv = v.shape[-1]
    L = GLA_CHUNK
    xs = tuple(to_chunks(t, L) for t in (q, k, v, log_a))
    mask = jnp.tril(jnp.ones((L, L), dtype=bool))
    init = jnp.zeros((B, H, dk, dv), jnp.float32)

    def step(state, inp):
        qc, kc, vc, ac = inp
        cum = jnp.cumsum(ac, axis=2)
        rel = cum[:, :, :, None, :] - cum[:, :, None, :, :]
        decay = jnp.exp(jnp.where(mask[:, :, None], rel, -jnp.inf))
        attn = jnp.einsum('bhtc,bhsc,bhtsc->bhts', qc, kc, decay)
        o = (jnp.einsum('bhts,bhsv->bhtv', attn, vc)
             + jnp.einsum('bhtc,bhcv->bhtv', qc * jnp.exp(cum), state))
        cL = cum[:, :, -1, :]
        state_new = (jnp.exp(cL)[..., None] * state
                     + jnp.einsum('bhsc,bhsv->bhcv', kc * jnp.exp(cL[:, :, None, :] - cum), vc))
        return state_new, o

    _, o = lax.scan(step, init, xs)
    return from_chunks(o)


def hybrid_mixer(u, w_in, w_conv, b_conv, b_igate, b_fgate, mlstm_norm_g,
                 w_gla_a, b_gla_a, gla_norm_g, w_out):
    B, S, _ = u.shape
    f32 = jnp.float32
    proj = u @ w_in
    points = [int(p) for p in np.cumsum(IN_SPLITS)[:-1]]
    mq, mk, mv, mo, mi, mf, gq, gk, gv, gg, ga = jnp.split(proj, points, axis=-1)

    def heads(t, h):
        return t.reshape(B, S, h, -1).astype(f32)

    qk = jax.nn.silu(causal_depthwise_conv(jnp.concatenate([mq, mk], -1), w_conv, b_conv))
    mq, mk = jnp.split(qk, 2, axis=-1)
    h_m = mlstm_chunkwise(
        heads(mq, MLSTM_HEADS),
        heads(mk, MLSTM_HEADS) * (MLSTM_HEAD_DIM ** -0.5),
        heads(mv, MLSTM_HEADS),
        (mi + b_igate).astype(f32),
        jax.nn.log_sigmoid((mf + b_fgate).astype(f32)))
    h_m = jax.nn.sigmoid(heads(mo, MLSTM_HEADS)) * h_m
    h_m = head_rms_norm(h_m, mlstm_norm_g)

    log_a = jax.nn.log_sigmoid((ga @ w_gla_a + b_gla_a).astype(f32)) / GLA_TAU
    h_g = gla_chunked(
        heads(gq, GLA_HEADS) * (GLA_DK ** -0.5),
        heads(gk, GLA_HEADS),
        heads(gv, GLA_HEADS),
        log_a.reshape(B, S, GLA_HEADS, GLA_DK))
    h_g = head_rms_norm(h_g, gla_norm_g) * jax.nn.silu(gg)

    return jnp.concatenate([h_m, h_g], axis=-1) @ w_out


def hierarchical_moe(u, w_rg, b_rg, w_re, b_re, w_gate, w_up, w_down):
    B, S, D = u.shape
    N = B * S
    hf = u.reshape(N, D)
    g_logits = (hf @ w_rg + b_rg).astype(jnp.float32)
    g_sel = jnp.argmax(g_logits, -1)
    p_g = jnp.take_along_axis(jax.nn.softmax(g_logits, -1), g_sel[:, None], 1)[:, 0]
    e_logits = (hf @ w_re + b_re).astype(jnp.float32).reshape(N, N_GROUPS, EXPERTS_PER_GROUP)
    e_in = jnp.take_along_axis(e_logits, g_sel[:, None, None], 1)[:, 0]
    top_v, top_i = lax.top_k(e_in, TOP_K_IN_GROUP)
    p_e = jax.nn.softmax(top_v, -1)
    expert_id = (g_sel[:, None] * EXPERTS_PER_GROUP + top_i).reshape(-1)
    weight = (p_g[:, None] * p_e).reshape(-1)
    order = jnp.argsort(expert_id)
    tok = order // TOP_K_IN_GROUP
    sizes = jnp.bincount(expert_id, length=N_EXPERTS).astype(jnp.int32)
    xs = hf[tok]
    hid = (jax.nn.silu(lax.ragged_dot(xs, w_gate, sizes))
           * lax.ragged_dot(xs, w_up, sizes))
    ys = lax.ragged_dot(hid, w_down, sizes) * weight[order][:, None].astype(hf.dtype)
    out = jnp.zeros((N, D), hf.dtype).at[tok].add(ys)
    return out.reshape(B, S, D)


def setup_inputs(seed: int = 0) -> dict:
    key = jax.random.key(seed)
    ks = jax.random.split(key, 26)
    f32 = jnp.float32
    D = D_MODEL
    Lr = DEPTH

    def nrm(k, shape, s):
        return jax.random.normal(k, shape, f32) * s

    col_scale = np.concatenate([
        np.ones(2 * MLSTM_WIDTH), np.full(MLSTM_WIDTH, DEEPNORM_BETA),
        np.ones(MLSTM_WIDTH + 2 * MLSTM_HEADS + 2 * GLA_HEADS * GLA_DK),
        np.full(GLA_WIDTH, DEEPNORM_BETA), np.ones(GLA_WIDTH + GLA_GATE_RANK)]).astype(np.float32)
    return {
        'x': nrm(ks[0], (BATCH, SEQ, D), 1.0),
        'c': nrm(ks[1], (BATCH, D), 1.0),
        'w_ada': nrm(ks[2], (Lr, D, 6 * D), 0.1 * D ** -0.5),
        'b_ada': nrm(ks[3], (Lr, 6 * D), 0.02),
        'w_in': nrm(ks[4], (Lr, D, IN_WIDTH), D ** -0.5) * jnp.asarray(col_scale),
        'w_conv': nrm(ks[5], (Lr, CONV_WIDTH, 2 * MLSTM_WIDTH), CONV_WIDTH ** -0.5),
        'b_conv': nrm(ks[6], (Lr, 2 * MLSTM_WIDTH), 0.02),
        'b_igate': nrm(ks[7], (Lr, MLSTM_HEADS), 0.1),
        'b_fgate': jnp.linspace(3.0, 6.0, MLSTM_HEADS, dtype=f32)[None] + nrm(ks[8], (Lr, MLSTM_HEADS), 0.1),
        'mlstm_norm_g': 1.0 + nrm(ks[9], (Lr, MLSTM_WIDTH), 0.02),
        'w_gla_a': nrm(ks[10], (Lr, GLA_GATE_RANK, GLA_HEADS * GLA_DK), GLA_GATE_RANK ** -0.5),
        'b_gla_a': nrm(ks[11], (Lr, GLA_HEADS * GLA_DK), 0.1),
        'gla_norm_g': 1.0 + nrm(ks[12], (Lr, GLA_WIDTH), 0.02),
        'w_out': nrm(ks[13], (Lr, MIX_WIDTH, D), MIX_WIDTH ** -0.5 * DEEPNORM_BETA),
        'ln1_g': 1.0 + nrm(ks[14], (Lr, D), 0.02),
        'ln1_b': nrm(ks[15], (Lr, D), 0.02),
        'w_route_group': nrm(ks[16], (Lr, D, N_GROUPS), D ** -0.5),
        'b_route_group': nrm(ks[17], (Lr, N_GROUPS), 0.01),
        'w_route_expert': nrm(ks[18], (Lr, D, N_EXPERTS), D ** -0.5),
        'b_route_expert': nrm(ks[19], (Lr, N_EXPERTS), 0.01),
        'w_gate': nrm(ks[20], (Lr, N_EXPERTS, D, D_EXPERT), D ** -0.5),
        'w_up': nrm(ks[21], (Lr, N_EXPERTS, D, D_EXPERT), D ** -0.5),
        'w_down': nrm(ks[22], (Lr, N_EXPERTS, D_EXPERT, D), D_EXPERT ** -0.5 * DEEPNORM_BETA),
        'ln2_g': 1.0 + nrm(ks[23], (Lr, D), 0.02),
        'ln2_b': nrm(ks[24], (Lr, D), 0.02),
    }


def reference(x, c, w_ada, b_ada, w_in, w_conv, b_conv, b_igate, b_fgate, mlstm_norm_g,
              w_gla_a, b_gla_a, gla_norm_g, w_out, ln1_g, ln1_b,
              w_route_group, b_route_group, w_route_expert, b_route_expert,
              w_gate, w_up, w_down, ln2_g, ln2_b):
    c_act = jax.nn.silu(c)
    for l in range(DEPTH):
        mod = c_act @ w_ada[l] + b_ada[l]
        sh1, sc1, g1, sh2, sc2, g2 = [m[:, None, :] for m in jnp.split(mod, 6, axis=-1)]
        u = x * (1.0 + sc1) + sh1
        y = hybrid_mixer(u, w_in[l], w_conv[l], b_conv[l], b_igate[l], b_fgate[l],
                         mlstm_norm_g[l], w_gla_a[l], b_gla_a[l], gla_norm_g[l], w_out[l])
        x = layer_norm(DEEPNORM_ALPHA * x + (1.0 + g1) * y, ln1_g[l], ln1_b[l])
        u = x * (1.0 + sc2) + sh2
        y = hierarchical_moe(u, w_route_group[l], b_route_group[l], w_route_expert[l],
                             b_route_expert[l], w_gate[l], w_up[l], w_down[l])
        x = layer_norm(DEEPNORM_ALPHA * x + (1.0 + g2) * y, ln2_g[l], ln2_b[l])
    return x
```

```cpp
#include <hip/hip_runtime.h>
#include <cstdio>
#include <cstdint>

#define GAS __attribute__((address_space(1)))
#define LAS __attribute__((address_space(3)))
typedef unsigned short bf16_t;
typedef short bf16x8 __attribute__((ext_vector_type(8)));
typedef float f32x4 __attribute__((ext_vector_type(4)));
typedef float f32x2 __attribute__((ext_vector_type(2)));
typedef unsigned u32x4 __attribute__((ext_vector_type(4)));
typedef unsigned u32x2 __attribute__((ext_vector_type(2)));

constexpr int D = 1024, BATCH = 8, SEQ = 2048, M = BATCH * SEQ;
constexpr int INW = 3608, NPROJ = 3584, NPAD = 3840;
constexpr int NCH = SEQ / 64;
constexpr int NEXP = 32, DEXP = 512, LISTCAP = 16384;
constexpr float LN_EPS = 1e-5f;
constexpr float DN_ALPHA = 1.189207115002721f;
constexpr int PC_MQ = 0, PC_MK = 512, PC_MV = 1024, PC_MO = 1536, PC_GQ = 2048, PC_GK = 2304, PC_GV = 2560, PC_GG = 3072;

constexpr size_t MiB = 1u << 20;
constexpr size_t WS_CTL = 0, CTL_ZERO_BYTES = 1 * MiB;
constexpr size_t WS_MOD = 1 * MiB;
constexpr size_t WS_WRT = 1 * MiB + 512 * 1024;
constexpr size_t WS_RTW = 2 * MiB;
constexpr size_t WS_GB = 2 * MiB + 256 * 1024;
constexpr size_t WS_GA = 2 * MiB + 512 * 1024;
constexpr size_t WS_MST = 2 * MiB + 768 * 1024;
constexpr size_t WS_NST = 3 * MiB;
constexpr size_t WS_LIST = 4 * MiB;
constexpr size_t WS_GATES = 6 * MiB;
constexpr size_t WS_WIN = 8 * MiB;
constexpr size_t WS_WOUT = 16 * MiB;
constexpr size_t WS_WGU = 18 * MiB;
constexpr size_t WS_WD = 82 * MiB;
constexpr size_t WS_SM = 114 * MiB;
constexpr size_t WS_SG = 146 * MiB;
constexpr size_t WS_HID = 114 * MiB;
constexpr size_t WS_PROJ = 162 * MiB;
constexpr size_t WS_Y = 162 * MiB;
constexpr size_t WS_U2 = 226 * MiB;
constexpr size_t WS_END = 274 * MiB;
constexpr size_t DO_U = 0, DO_KT = 0, DO_HCAT = 32 * MiB, DO_Y2 = 0;

constexpr int CW_TMO = 0;
constexpr int CW_BAR = 4096;
constexpr int CW_ECNT = 16384;
constexpr int CW_DBG = 32768;

constexpr int RING_BYTES = 131072;
constexpr int LDSCTL_OFF = RING_BYTES, MISC_OFF = LDSCTL_OFF + 320;
constexpr int MOE_OFF = LDSCTL_OFF + 1024;
constexpr int LDS_BYTES = 147456;
constexpr int NWAVES = 8, NT = 512;

#define RLX_AGENT __ATOMIC_RELAXED, __HIP_MEMORY_SCOPE_AGENT
#define LDS_WAIT() asm volatile("s_waitcnt lgkmcnt(0)" ::: "memory")
#define VM_WAIT() asm volatile("s_waitcnt vmcnt(0)" ::: "memory")

__device__ __forceinline__ unsigned f2bf(float f) { unsigned u = __builtin_bit_cast(unsigned, f); return (u + 0x7fffu + ((u >> 16) & 1u)) >> 16; }
__device__ __forceinline__ unsigned pk2(float lo, float hi) { return f2bf(lo) | (f2bf(hi) << 16); }
__device__ __forceinline__ float bf2f(unsigned short h) { return __builtin_bit_cast(float, (unsigned)h << 16); }
__device__ __forceinline__ float bflo(unsigned w) { return __builtin_bit_cast(float, w << 16); }
__device__ __forceinline__ float bfhi(unsigned w) { return __builtin_bit_cast(float, w & 0xffff0000u); }
__device__ __forceinline__ float sigmoidf_(float x) { return 1.0f / (1.0f + __expf(-x)); }
__device__ __forceinline__ float siluf_(float x) { return x / (1.0f + __expf(-x)); }
__device__ __forceinline__ float logsigf_(float x) { return fminf(x, 0.0f) - log1pf(__expf(-fabsf(x))); }
__device__ __forceinline__ float wave_sum(float v) {
#pragma unroll
    for (int o = 1; o < 64; o <<= 1) v += __shfl_xor(v, o);
    return v;
}
__device__ __forceinline__ float wave_max(float v) {
#pragma unroll
    for (int o = 1; o < 64; o <<= 1) v = fmaxf(v, __shfl_xor(v, o));
    return v;
}
__device__ __forceinline__ float wave_scan_add(float v, int lane) {
#pragma unroll
    for (int o = 1; o < 64; o <<= 1) { float t = __shfl_up(v, o); if (lane >= o) v += t; }
    return v;
}
__device__ __forceinline__ float wave_scan_max(float v, int lane) {
#pragma unroll
    for (int o = 1; o < 64; o <<= 1) { float t = __shfl_up(v, o); if (lane >= o) v = fmaxf(v, t); }
    return v;
}

#define XB_TMO      128
#define XB_XCNT(j)  (256  + 64 * (j))
#define XB_XSUB(j)  (1280 + 64 * (j))
#define XB_XGEN(j)  (2304 + 64 * (j))
#define XB_TOP      3328
#define XB_TOPGEN   3392
#define XCD_BAR_WORDS 3456
#define XB_SPIN_CAP (1u << 18)
__device__ __forceinline__ unsigned xb_ld(unsigned* p)              { return __hip_atomic_load(p, __ATOMIC_RELAXED, __HIP_MEMORY_SCOPE_AGENT); }
__device__ __forceinline__ unsigned xb_add(unsigned* p, unsigned v) { return __hip_atomic_fetch_add(p, v, __ATOMIC_RELAXED, __HIP_MEMORY_SCOPE_AGENT); }
__device__ __forceinline__ unsigned xb_xcc_id() { return (unsigned)__builtin_amdgcn_s_getreg((3 << 11) | 20) & 0xFu; }
#define XB_SPIN(cond, bar) do { unsigned _sp = 0; while (cond) { __builtin_amdgcn_s_sleep(1); \
    if ((++_sp & 255u) == 0u) { if (xb_ld(&(bar)[XB_TMO])) break; if (_sp > XB_SPIN_CAP) { atomicAdd(&(bar)[XB_TMO], 1u); break; } } } } while (0)
struct XcdBarrier { unsigned* bar; unsigned x; volatile LAS unsigned* st; };
__device__ __forceinline__ XcdBarrier xcd_barrier_post(unsigned* bar, volatile LAS unsigned* st) {
    XcdBarrier b; b.bar = bar; b.x = xb_xcc_id(); b.st = st;
    if (threadIdx.x == 0) (void)xb_add(&bar[XB_XCNT(b.x)], 1u);
    return b;
}
__device__ __forceinline__ void xcd_barrier_complete(unsigned* bar, unsigned x, unsigned& nloc, unsigned& nx) {
    const unsigned G = gridDim.x * gridDim.y * gridDim.z;
    unsigned sum, cnt, mine, sp = 0u;
    for (;;) {
        sum = 0u; cnt = 0u; mine = 0u;
#pragma unroll
        for (unsigned j = 0; j < 16; ++j) { const unsigned c = xb_ld(&bar[XB_XCNT(j)]); sum += c; cnt += (c > 0u) ? 1u : 0u; mine = (j == x) ? c : mine; }
        if (sum == G) break;
        __builtin_amdgcn_s_sleep(1);
        if ((++sp & 255u) == 0u) { if (xb_ld(&bar[XB_TMO])) break; if (sp > XB_SPIN_CAP) { atomicAdd(&bar[XB_TMO], 1u); break; } }
    }
    nloc = mine > 0u ? mine : 1u; nx = cnt > 0u ? cnt : 1u;
}
__device__ __forceinline__ void xcd_barrier(const XcdBarrier& b) {
    asm volatile("s_waitcnt vmcnt(0)" ::: "memory");
    __syncthreads();
    if (threadIdx.x == 0) {
        unsigned* bar = b.bar;
        __builtin_amdgcn_s_waitcnt(0);
        unsigned nloc = b.st[0], nx = b.st[1];
        if (nloc == 0u) { xcd_barrier_complete(bar, b.x, nloc, nx); b.st[0] = nloc; b.st[1] = nx; }
        const unsigned old = xb_add(&bar[XB_XSUB(b.x)], 1u);
        const unsigned gen = old / nloc;
        if (old + 1u == (gen + 1u) * nloc) {
            __builtin_amdgcn_fence(__ATOMIC_RELEASE, "agent");
            asm volatile("s_waitcnt vmcnt(0)" ::: "memory");
            const unsigned og = xb_add(&bar[XB_TOP], 1u);
            const unsigned tg = og / nx;
            if (og + 1u == (tg + 1u) * nx) xb_add(&bar[XB_TOPGEN], 1u);
            else XB_SPIN(xb_ld(&bar[XB_TOPGEN]) == tg, bar);
            __builtin_amdgcn_fence(__ATOMIC_ACQUIRE, "agent");
            xb_add(&bar[XB_XGEN(b.x)], 1u);
            asm volatile("s_waitcnt vmcnt(0)" ::: "memory");
        } else {
            XB_SPIN(xb_ld(&bar[XB_XGEN(b.x)]) == gen, bar);
            __builtin_amdgcn_fence(__ATOMIC_ACQUIRE, "agent");
            asm volatile("s_waitcnt vmcnt(0)" ::: "memory");
        }
    }
    __syncthreads();
}

namespace pg8 {
constexpr int BM = 256, BK = 64, HALF = 128, HTB = HALF * BK * 2, STAGE_BYTES = 8 * HTB, NXCD = 8, WGM = 8;
__host__ __device__ __forceinline__ int lds_byte(int r, int c) { const int st = (r >> 4) * 2 + (c >> 5), rr = r & 15, cc = c & 31, ob = rr * 64 + cc * 2; return st * 1024 + (ob ^ (((ob >> 9) & 1) << 5)); }
__host__ __device__ __forceinline__ void stage_rc(int b, int& R, int& C) { const int st = b / 1024, sb = b % 1024, swz = sb ^ (((sb >> 9) & 1) << 5); R = (st >> 1) * 16 + swz / 64; C = (st & 1) * 32 + (swz % 64) / 2; }
__host__ __device__ __forceinline__ int perm32(int rho) { const int n = rho >> 4, i = rho & 15; return 8 * (i >> 2) + 4 * n + (i & 3); }
__device__ __forceinline__ unsigned cvt_pk_bf16(float lo, float hi) { unsigned r; asm volatile("v_cvt_pk_bf16_f32 %0, %1, %2" : "=v"(r) : "v"(lo), "v"(hi)); return r; }

struct GUnit { const char* A; const char* B; const int* rows; int nvalid, pm, pn, e, orow0; };

struct DenseSched {
    const char* A; const char* Bt; int K, nM, nN, nwg, G, c;
    __device__ void init(const void* A_, const void* Bt_, int M_, int N_, int K_, int G_, int c_) { A = (const char*)A_; Bt = (const char*)Bt_; K = K_; nM = M_ / BM; nN = N_ / BM; nwg = nM * nN; G = G_; c = c_; }
    __device__ bool next(int i, GUnit& u) const {
        const long L = (long)i * G + c; if (L >= nwg) return false;
        int wgid = (int)L; { const int q = nwg / NXCD, r = nwg % NXCD, xcd = wgid % NXCD, off = wgid / NXCD; wgid = (xcd < r ? xcd * (q + 1) : r * (q + 1) + (xcd - r) * q) + off; }
        const int nig = WGM * nN, gid = wgid / nig, fm = gid * WGM, gsz = (nM - fm) < WGM ? (nM - fm) : WGM;
        u.pm = fm + ((wgid % nig) % gsz); u.pn = (wgid % nig) / gsz;
        u.A = A + (size_t)u.pm * BM * K * 2; u.B = Bt + (size_t)u.pn * BM * K * 2; u.rows = nullptr; u.nvalid = BM; u.e = 0; u.orow0 = u.pm * BM;
        return true;
    }
};
struct MoeSched {
    const char* A; const char* Bt; size_t bstride; int K; const LAS int* tab; const int* list; int G, c; bool gather;
    __device__ bool next(int i, GUnit& u) const {
        const int nrt = tab[32], nwg = nrt * 4;
        const long L = (long)i * G + c; if (L >= nwg) return false;
        int wgid = (int)L; { const int q = nwg / NXCD, r = nwg % NXCD, xcd = wgid % NXCD, off = wgid / NXCD; wgid = (xcd < r ? xcd * (q + 1) : r * (q + 1) + (xcd - r) * q) + off; }
        const int rt = wgid >> 2; u.pn = wgid & 3;
        int e = 0;
        for (int j = 1; j < 32; ++j) if (tab[j] <= rt) e = j;
        const int mt = rt - tab[e];
        u.e = e; u.pm = mt; const int left = tab[66 + e] - BM * mt; u.nvalid = left < BM ? left : BM;
        u.rows = list + (size_t)e * LISTCAP + BM * mt; u.orow0 = tab[33 + e] + BM * mt;
        u.A = gather ? A : A + (size_t)u.orow0 * K * 2; u.B = Bt + (size_t)e * bstride + (size_t)u.pn * BM * K * 2;
        return true;
    }
};

template <bool GATHER, bool ALIGN_EPI, class Epi, class Sched>
__device__ __forceinline__ void gemm_phase(LAS unsigned char* lds, const int K, const Sched& S, const Epi& E) {
    int tid_ = threadIdx.x; asm volatile("" : "+v"(tid_));
    const int tid = tid_, wid = __builtin_amdgcn_readfirstlane(tid >> 6), lane = tid & 63, wr = wid >> 2, wc = wid & 3, fr = lane & 15, fq = lane >> 4;
    const int nt = K / BK;
    unsigned voffB[2];
#pragma unroll
    for (int i = 0; i < 2; ++i) { int R, C; stage_rc(tid * 16 + i * 8192, R, C); const int Rb = Epi::PERM ? ((R & ~31) + perm32(R & 31)) : R; voffB[i] = (unsigned)(Rb * K + C) * 2u; }
    const size_t kstep = (size_t)(BK * 2);
    const size_t hstep = (size_t)HALF * K * 2;
    const unsigned ldsw = (unsigned)wid * 1024u;
    const int aoff = lds_byte(wr * 64 + fr, fq * 8), boff = lds_byte(wc * 32 + fr, fq * 8);
#define PG8_SA(b, h) (((b) * 2 + (h)) * HTB)
#define PG8_SB(b, h) ((4 + (b) * 2 + (h)) * HTB)
#define PG8_STAGE(bufoff, gbase, voff) do { _Pragma("unroll") for (int _i = 0; _i < 2; ++_i) \
        __builtin_amdgcn_global_load_lds((const unsigned*)((const char*)(gbase) + (voff)[_i]), (LAS unsigned*)(lds + (bufoff) + ldsw + _i * 8192), 16, 0, 0); } while (0)
#define PG8_LDA(dst, b, h) do { _Pragma("unroll") for (int m = 0; m < 4; ++m) _Pragma("unroll") for (int k = 0; k < 2; ++k) dst[m][k] = *(const LAS bf16x8*)(lds + PG8_SA(b, h) + aoff + m * 2048 + k * 1024); } while (0)
#define PG8_LDB(dst, b, h) do { _Pragma("unroll") for (int n = 0; n < 2; ++n) _Pragma("unroll") for (int k = 0; k < 2; ++k) dst[n][k] = *(const LAS bf16x8*)(lds + PG8_SB(b, h) + boff + n * 2048 + k * 1024); } while (0)
#define PG8_MMA(ai, bj, At, Bt) do { __builtin_amdgcn_s_setprio(1); _Pragma("unroll") for (int m = 0; m < 4; ++m) _Pragma("unroll") for (int n = 0; n < 2; ++n) _Pragma("unroll") for (int k = 0; k < 2; ++k) \
        acc[ai][bj][m][n] = __builtin_amdgcn_mfma_f32_16x16x32_bf16(Bt[n][k], At[m][k], acc[ai][bj][m][n], 0, 0, 0); __builtin_amdgcn_s_setprio(0); } while (0)
#define PG8_WAIT_V(n) asm volatile("s_waitcnt vmcnt(" #n ")" ::: "memory")
#define PG8_WAIT_L(n) asm volatile("s_waitcnt lgkmcnt(" #n ")" ::: "memory")
#define PG8_BAR __builtin_amdgcn_s_barrier()
#define PG8_SCHED __builtin_amdgcn_sched_barrier(0)
#define PG8_MKVA(u, v0, v1) do { _Pragma("unroll") for (int _i = 0; _i < 2; ++_i) { int _R, _C; stage_rc(tid * 16 + _i * 8192, _R, _C); \
        if (GATHER) { const int _r0 = _R, _r1 = HALF + _R; const int _id0 = _r0 < (u).nvalid ? (u).rows[_r0] : 0; const int _id1 = _r1 < (u).nvalid ? (u).rows[_r1] : 0; \
            v0[_i] = (unsigned)((_id0 >> 1) * K + _C) * 2u; v1[_i] = (unsigned)((_id1 >> 1) * K + _C) * 2u; } \
        else { v0[_i] = (unsigned)(_R * K + _C) * 2u; v1[_i] = v0[_i] + (unsigned)hstep; } } } while (0)
    GUnit cur, nxt; int ui = 0;
    if (!S.next(0, cur)) return;
    f32x4 acc[2][2][4][2];
#pragma unroll
    for (int a = 0; a < 2; ++a)
#pragma unroll
        for (int b = 0; b < 2; ++b)
#pragma unroll
            for (int m = 0; m < 4; ++m)
#pragma unroll
                for (int n = 0; n < 2; ++n) acc[a][b][m][n] = (f32x4){0.f, 0.f, 0.f, 0.f};
    bf16x8 At[4][2], B0[2][2], B1[2][2];
    unsigned cva0[2], cva1[2];
    const char* cA = cur.A; const char* cB = cur.B;
    PG8_MKVA(cur, cva0, cva1);
    PG8_STAGE(PG8_SB(0, 0), cB, voffB); PG8_STAGE(PG8_SB(0, 1), cB + hstep, voffB); PG8_STAGE(PG8_SA(0, 0), cA, cva0); PG8_STAGE(PG8_SA(0, 1), cA, cva1);
    if (wr == 1) PG8_BAR;
    PG8_WAIT_V(2); PG8_BAR;
    PG8_STAGE(PG8_SB(1, 0), cB + kstep, voffB); PG8_STAGE(PG8_SA(1, 0), cA + kstep, cva0); PG8_STAGE(PG8_SB(1, 1), cB + hstep + kstep, voffB);
    PG8_WAIT_V(6); PG8_BAR;
    for (;;) {
        const bool has_next = S.next(ui + 1, nxt);
        const char* nA = has_next ? nxt.A : cA; const char* nB = has_next ? nxt.B : cB;
        for (int t = 0; t < nt; t += 2) {
            const bool last = (t == nt - 2);
            const char* a1 = cA + (size_t)(t + 1) * kstep;
            const char* a2 = last ? nA : cA + (size_t)(t + 2) * kstep; const char* b2 = last ? nB : cB + (size_t)(t + 2) * kstep;
            const char* a3 = a2 + kstep; const char* b3 = b2 + kstep;
            PG8_LDB(B0, 0, 0); PG8_LDB(B1, 0, 1); PG8_SCHED; PG8_LDA(At, 0, 0); PG8_STAGE(PG8_SA(1, 1), a1, cva1);
            PG8_WAIT_V(8); PG8_WAIT_L(0); PG8_BAR; PG8_MMA(0, 0, At, B0); PG8_MMA(0, 1, At, B1); PG8_BAR; PG8_SCHED;
            if (GATHER) { if (last && has_next) PG8_MKVA(nxt, cva0, cva1); }
            PG8_LDA(At, 0, 1); PG8_STAGE(PG8_SB(0, 0), b2, voffB); PG8_STAGE(PG8_SB(0, 1), b2 + hstep, voffB); PG8_STAGE(PG8_SA(0, 0), a2, cva0);
            PG8_WAIT_V(8); PG8_WAIT_L(0); PG8_BAR; PG8_MMA(1, 0, At, B0); PG8_MMA(1, 1, At, B1); PG8_BAR; PG8_SCHED;
            PG8_LDB(B0, 1, 0); PG8_LDB(B1, 1, 1); PG8_SCHED; PG8_LDA(At, 1, 0); PG8_STAGE(PG8_SA(0, 1), a2, cva1);
            PG8_WAIT_V(8); PG8_WAIT_L(0); PG8_BAR; PG8_MMA(0, 0, At, B0); PG8_MMA(0, 1, At, B1); PG8_BAR; PG8_SCHED;
            PG8_LDA(At, 1, 1); PG8_STAGE(PG8_SB(1, 0), b3, voffB); PG8_STAGE(PG8_SB(1, 1), b3 + hstep, voffB); PG8_STAGE(PG8_SA(1, 0), a3, cva0);
            PG8_WAIT_V(8); PG8_WAIT_L(0); PG8_BAR; PG8_MMA(1, 0, At, B0); PG8_MMA(1, 1, At, B1); PG8_BAR; PG8_SCHED;
        }
        if constexpr (ALIGN_EPI) { if (wr == 0) PG8_BAR; }
        E(acc, cur, wr, wc, fr, fq);
        if (!has_next) break;
#pragma unroll
        for (int a = 0; a < 2; ++a)
#pragma unroll
            for (int b = 0; b < 2; ++b)
#pragma unroll
                for (int m = 0; m < 4; ++m)
#pragma unroll
                    for (int n = 0; n < 2; ++n) acc[a][b][m][n] = (f32x4){0.f, 0.f, 0.f, 0.f};
        cur = nxt; cA = nA; cB = nB; ++ui;
        if constexpr (ALIGN_EPI) { if (wr == 1) PG8_BAR; }
    }
    PG8_WAIT_V(0);
    if constexpr (!ALIGN_EPI) { if (wr == 0) PG8_BAR; }
    PG8_BAR;
#undef PG8_SA
#undef PG8_SB
#undef PG8_STAGE
#undef PG8_LDA
#undef PG8_LDB
#undef PG8_MMA
#undef PG8_WAIT_V
#undef PG8_WAIT_L
#undef PG8_BAR
#undef PG8_SCHED
#undef PG8_MKVA
}
}

struct Args { const float* in[25]; float* out; unsigned char* ws; };
struct Frame {
    LAS unsigned char* lds;
    unsigned* ctl;
    int tid, lane, wave, vcu, G;
    float* out; unsigned char* ws; unsigned char* dob;
};

using pg8::GUnit; using pg8::cvt_pk_bf16;
struct EpiProj {
    static constexpr bool PERM = true;
    bf16_t* proj; float* gates;
    __device__ __forceinline__ void operator()(const f32x4 (&acc)[2][2][4][2], const GUnit& u, int wr, int wc, int fr, int fq) const {
        const int row0 = u.pm * 256 + wr * 64 + fr;
        if (u.pn < 14) {
            const int col0 = u.pn * 256 + wc * 32 + 8 * fq;
#pragma unroll
            for (int ai = 0; ai < 2; ++ai)
#pragma unroll
                for (int m = 0; m < 4; ++m) { bf16_t* rowp = proj + (size_t)(row0 + ai * 128 + m * 16) * NPROJ + col0;
#pragma unroll
                    for (int bj = 0; bj < 2; ++bj) { const f32x4 v0 = acc[ai][bj][m][0], v1 = acc[ai][bj][m][1];
                        u32x4 w; w.x = cvt_pk_bf16(v0[0], v0[1]); w.y = cvt_pk_bf16(v0[2], v0[3]); w.z = cvt_pk_bf16(v1[0], v1[1]); w.w = cvt_pk_bf16(v1[2], v1[3]);
                        *(u32x4*)(rowp + bj * 128) = w; } }
        } else if (wc == 0) {
#pragma unroll
            for (int ai = 0; ai < 2; ++ai)
#pragma unroll
                for (int m = 0; m < 4; ++m) { float* g = gates + (size_t)(row0 + ai * 128 + m * 16) * 32 + 8 * fq;
                    *(f32x4*)(g) = acc[ai][0][m][0]; *(f32x4*)(g + 4) = acc[ai][0][m][1]; }
        }
    }
};
struct EpiF32 {
    static constexpr bool PERM = false;
    float* C;
    __device__ __forceinline__ void operator()(const f32x4 (&acc)[2][2][4][2], const GUnit& u, int wr, int wc, int fr, int fq) const {
        const int row0 = u.pm * 256 + wr * 64 + fr, col0 = u.pn * 256 + wc * 32 + 4 * fq;
#pragma unroll
        for (int ai = 0; ai < 2; ++ai)
#pragma unroll
            for (int m = 0; m < 4; ++m) { float* rowp = C + (size_t)(row0 + ai * 128 + m * 16) * D + col0;
#pragma unroll
                for (int bj = 0; bj < 2; ++bj)
#pragma unroll
                    for (int n = 0; n < 2; ++n) *(f32x4*)(rowp + bj * 128 + n * 16) = acc[ai][bj][m][n]; }
    }
};
struct EpiHid {
    static constexpr bool PERM = true;
    bf16_t* hid;
    __device__ __forceinline__ void operator()(const f32x4 (&acc)[2][2][4][2], const GUnit& u, int wr, int wc, int fr, int fq) const {
        const int row0 = u.orow0 + wr * 64 + fr, col0 = u.pn * 128 + wc * 32 + 8 * fq;
#pragma unroll
        for (int ai = 0; ai < 2; ++ai)
#pragma unroll
            for (int m = 0; m < 4; ++m) { bf16_t* rowp = hid + (size_t)(row0 + ai * 128 + m * 16) * DEXP + col0;
                float h[8];
#pragma unroll
                for (int n = 0; n < 2; ++n)
#pragma unroll
                    for (int i = 0; i < 4; ++i) { const float g = acc[ai][0][m][n][i], up = acc[ai][1][m][n][i]; h[n * 4 + i] = siluf_(g) * up; }
                u32x4 w; w.x = cvt_pk_bf16(h[0], h[1]); w.y = cvt_pk_bf16(h[2], h[3]); w.z = cvt_pk_bf16(h[4], h[5]); w.w = cvt_pk_bf16(h[6], h[7]);
                *(u32x4*)(rowp) = w; }
    }
};
struct EpiY2 {
    static constexpr bool PERM = true;
    bf16_t* y2; const float* rtw;
    __device__ __forceinline__ void operator()(const f32x4 (&acc)[2][2][4][2], const GUnit& u, int wr, int wc, int fr, int fq) const {
        const int col0 = u.pn * 256 + wc * 32 + 8 * fq;
#pragma unroll
        for (int ai = 0; ai < 2; ++ai)
#pragma unroll
            for (int m = 0; m < 4; ++m) { const int r = ai * 128 + wr * 64 + m * 16 + fr;
                if (r < u.nvalid) { const int idx = u.rows[r]; const float wgt = rtw[idx]; bf16_t* rowp = y2 + (size_t)idx * D + col0;
#pragma unroll
                    for (int bj = 0; bj < 2; ++bj) { const f32x4 v0 = acc[ai][bj][m][0] * wgt, v1 = acc[ai][bj][m][1] * wgt;
                        u32x4 w; w.x = cvt_pk_bf16(v0[0], v0[1]); w.y = cvt_pk_bf16(v0[2], v0[3]); w.z = cvt_pk_bf16(v1[0], v1[1]); w.w = cvt_pk_bf16(v1[2], v1[3]);
                        *(u32x4*)(rowp + bj * 128) = w; } } }
    }
};

template <class ColFn>
__device__ __forceinline__ void transpose_item(const float* W, int ldw, int K, bf16_t* WT, int k0, LAS float* scr, int lane, ColFn colfn) {
    const int col = colfn(lane & 31);
#pragma unroll 8
    for (int i = 0; i < 32; ++i) { const int kk = 2 * i + (lane >> 5); scr[kk * 33 + (lane & 31)] = col >= 0 ? W[(size_t)(k0 + kk) * ldw + col] : 0.f; }
    LDS_WAIT(); asm volatile("" ::: "memory");
    const int c = lane & 7;
#pragma unroll
    for (int j = 0; j < 4; ++j) { const int n = (lane >> 3) + 8 * j; const LAS float* s = scr + (8 * c) * 33 + n;
        u32x4 o; o.x = pk2(s[0 * 33], s[1 * 33]); o.y = pk2(s[2 * 33], s[3 * 33]); o.z = pk2(s[4 * 33], s[5 * 33]); o.w = pk2(s[6 * 33], s[7 * 33]);
        *(u32x4*)(WT + (size_t)n * K + k0 + 8 * c) = o; }
    LDS_WAIT(); asm volatile("" ::: "memory");
}
__device__ __forceinline__ int win_orig_col(int np) {
    if (np < 2048) return np;
    if (np < 3584) return np + 8;
    if (np < 3592) return 2048 + (np - 3584);
    if (np < 3608) return np;
    return -1;
}
__device__ __forceinline__ void p0_adaln_item(Frame& F, const Args& args, int it) {
    LAS float* cact = (LAS float*)F.lds;
    LAS float* red = cact + 8192;
    for (int i = F.tid; i < 8192; i += NT) cact[i] = siluf_(args.in[1][i]);
    __syncthreads();
    const int j = it * 64 + F.lane;
    float a[8];
#pragma unroll
    for (int b = 0; b < 8; ++b) a[b] = 0.f;
    const int kb = F.wave * 128;
#pragma unroll 4
    for (int k = kb; k < kb + 128; ++k) { const float w = args.in[2][(size_t)k * 6144 + j];
#pragma unroll
        for (int b = 0; b < 8; ++b) a[b] += cact[b * 1024 + k] * w; }
#pragma unroll
    for (int b = 0; b < 8; ++b) red[(F.wave * 8 + b) * 64 + F.lane] = a[b];
    __syncthreads();
    { const int b = F.tid >> 6, l = F.tid & 63; float s = 0.f;
#pragma unroll
      for (int w = 0; w < 8; ++w) s += red[(w * 8 + b) * 64 + l];
      float* mod = (float*)(F.ws + WS_MOD); mod[b * 6144 + it * 64 + l] = s + args.in[3][it * 64 + l]; }
    __syncthreads();
}
__device__ __forceinline__ void p0_prologue(Frame& F, const Args& args) {
    for (int it = blockIdx.x; it < 96; it += F.G) p0_adaln_item(F, args, it);
    LAS float* scr = (LAS float*)(F.lds + F.wave * 16384);
    const int gw = F.vcu * NWAVES + F.wave, NGW = F.G * NWAVES;
    constexpr int I_IN = (NPAD / 32) * 16, I_OUT = 32 * 16, I_GU = NEXP * 32 * 16, I_D = NEXP * 32 * 8;
    constexpr int NITEMS = I_IN + I_OUT + I_GU + I_D;
    bf16_t* WIN = (bf16_t*)(F.ws + WS_WIN); bf16_t* WOUT = (bf16_t*)(F.ws + WS_WOUT); bf16_t* WGU = (bf16_t*)(F.ws + WS_WGU); bf16_t* WD = (bf16_t*)(F.ws + WS_WD);
    for (int it = gw; it < NITEMS; it += NGW) {
        int r = it;
        if (r < I_IN) { const int nb = r >> 4, kb = r & 15; const int n0 = nb * 32;
            transpose_item(args.in[4], INW, D, WIN + (size_t)n0 * D, kb * 64, scr, F.lane, [n0](int n) { return win_orig_col(n0 + n); }); continue; }
        r -= I_IN;
        if (r < I_OUT) { const int nb = r >> 4, kb = r & 15; const int n0 = nb * 32;
            transpose_item(args.in[13], D, D, WOUT + (size_t)n0 * D, kb * 64, scr, F.lane, [n0](int n) { return n0 + n; }); continue; }
        r -= I_OUT;
        if (r < I_GU) { const int e = r >> 9, rr = r & 511, nb = rr >> 4, kb = rr & 15; const int row0 = nb * 32;
            const int pn = row0 >> 8, half = (row0 >> 7) & 1, j0 = row0 & 127; const int c0 = pn * 128 + j0;
            const float* src = (half ? args.in[21] : args.in[20]) + (size_t)e * D * DEXP;
            transpose_item(src, DEXP, D, WGU + ((size_t)e * 1024 + row0) * D, kb * 64, scr, F.lane, [c0](int n) { return c0 + n; }); continue; }
        r -= I_GU;
        { const int e = r >> 8, rr = r & 255, nb = rr >> 3, kb = rr & 7; const int n0 = nb * 32;
          const float* src = args.in[22] + (size_t)e * DEXP * D;
          transpose_item(src, D, DEXP, WD + ((size_t)e * 1024 + n0) * DEXP, kb * 64, scr, F.lane, [n0](int n) { return n0 + n; }); }
    }
    float* WRT = (float*)(F.ws + WS_WRT);
    for (int i = blockIdx.x * NT + F.tid; i < 36 * 1024; i += F.G * NT) { const int e = i >> 10, k = i & 1023; WRT[i] = e < 4 ? args.in[16][k * 4 + e] : args.in[18][k * 32 + (e - 4)]; }
}
__device__ __forceinline__ void p1_modulate(Frame& F, const Args& args) {
    const float* mod = (const float*)(F.ws + WS_MOD); bf16_t* U = (bf16_t*)(F.dob + DO_U);
    const int gw = F.vcu * NWAVES + F.wave, NGW = F.G * NWAVES;
    for (int t = gw; t < M; t += NGW) {
        const int b = t >> 11; const float* sh = mod + b * 6144; const float* sc = sh + 1024;
        const f32x4* xr = (const f32x4*)(args.in[0] + (size_t)t * D) + F.lane; u32x2* o = (u32x2*)(U + (size_t)t * D) + F.lane;
#pragma unroll
        for (int j = 0; j < 4; ++j) { const f32x4 v = xr[64 * j]; const f32x4 s = *((const f32x4*)sc + F.lane + 64 * j), h = *((const f32x4*)sh + F.lane + 64 * j);
            const f32x4 r = v * (s + 1.0f) + h; u32x2 w; w.x = pk2(r[0], r[1]); w.y = pk2(r[2], r[3]); o[64 * j] = w; }
    }
}

__device__ __forceinline__ void p3_mlstm_item(Frame& F, const Args& args, int item) {
    const int ks = item & 3, bh = item >> 2, b = bh >> 2, h = bh & 3, tid = F.tid, lane = F.lane;
    LAS float* kraw = (LAS float*)F.lds;
    LAS float* ktw = kraw + 67 * 33;
    LAS float* vs = ktw + 64 * 33;
    LAS float* wsL = vs + 64 * 128;
    LAS float* scl = wsL + 64;
    const bf16_t* proj = (const bf16_t*)(F.ws + WS_PROJ); const float* gates = (const float*)(F.ws + WS_GATES);
    bf16_t* KT = (bf16_t*)(F.dob + DO_KT); bf16_t* SM = (bf16_t*)(F.ws + WS_SM);
    float* GB = (float*)(F.ws + WS_GB); float* GA = (float*)(F.ws + WS_GA); float* MST = (float*)(F.ws + WS_MST); float* NST = (float*)(F.ws + WS_NST);
    const int kcol = PC_MK + h * 128 + ks * 32, vcol = PC_MV + h * 128;
    const int cs = tid >> 3, c4 = tid & 7;
    float wcv[4][4], bcv[4];
#pragma unroll
    for (int e = 0; e < 4; ++e) { const int ch = 512 + h * 128 + ks * 32 + c4 * 4 + e; bcv[e] = args.in[6][ch];
#pragma unroll
        for (int j = 0; j < 4; ++j) wcv[j][e] = args.in[5][j * 1024 + ch]; }
    const float big = args.in[7][h], bfg = args.in[8][h];
    const int ci = tid >> 4, jg = tid & 15;
    float C[8]; float nacc = 0.f, mrun = 0.f;
#pragma unroll
    for (int e = 0; e < 8; ++e) C[e] = 0.f;
    u32x2 pk_main, pk_halo; u32x4 pv[2]; float pgi = 0.f, pgf = 0.f;
#define P3M_PREFETCH(c_) do { const int t0_ = b * SEQ + (c_) * 64; \
        pk_main = *(const u32x2*)(proj + (size_t)(t0_ + (tid >> 3)) * NPROJ + kcol + (tid & 7) * 4); \
        pk_halo = (u32x2){0u, 0u}; if (tid < 24 && (c_) > 0) pk_halo = *(const u32x2*)(proj + (size_t)(t0_ - 3 + (tid >> 3)) * NPROJ + kcol + (tid & 7) * 4); \
        _Pragma("unroll") for (int q_ = 0; q_ < 2; ++q_) { const int p_ = tid + 512 * q_; pv[q_] = *(const u32x4*)(proj + (size_t)(t0_ + (p_ >> 4)) * NPROJ + vcol + (p_ & 15) * 8); } \
        if (tid < 64) { pgi = gates[(size_t)(t0_ + tid) * 32 + h]; pgf = gates[(size_t)(t0_ + tid) * 32 + 4 + h]; } } while (0)
    P3M_PREFETCH(0);
    for (int c = 0; c < NCH; ++c) {
        const int t0 = b * SEQ + c * 64;
        { const int r = tid >> 3, cc = (tid & 7) * 4; LAS float* d = kraw + (r + 3) * 33 + cc; d[0] = bflo(pk_main.x); d[1] = bfhi(pk_main.x); d[2] = bflo(pk_main.y); d[3] = bfhi(pk_main.y);
          if (tid < 24) { LAS float* d2 = kraw + r * 33 + cc; d2[0] = bflo(pk_halo.x); d2[1] = bfhi(pk_halo.x); d2[2] = bflo(pk_halo.y); d2[3] = bfhi(pk_halo.y); } }
#pragma unroll
        for (int q = 0; q < 2; ++q) { const int p = tid + 512 * q; LAS float* d = vs + (p >> 4) * 128 + (p & 15) * 8;
            d[0] = bflo(pv[q].x); d[1] = bfhi(pv[q].x); d[2] = bflo(pv[q].y); d[3] = bfhi(pv[q].y); d[4] = bflo(pv[q].z); d[5] = bfhi(pv[q].z); d[6] = bflo(pv[q].w); d[7] = bfhi(pv[q].w); }
        if (tid < 64) {
            const float ig = pgi + big, lf = logsigf_(pgf + bfg);
            const float bc = wave_scan_add(lf, lane), bL = __shfl(bc, 63);
            const float a = ig - bc, wl = bL - bc + ig;
            const float wmax = wave_max(wl), mnew = fmaxf(bL + mrun, wmax);
            wsL[lane] = __expf(wl - mnew);
            if (lane == 0) scl[0] = __expf(bL + mrun - mnew);
            if (ks == 0) { GB[(size_t)(t0 + lane) * 4 + h] = bc; GA[(size_t)(t0 + lane) * 4 + h] = a; if (lane == 0) MST[bh * 32 + c] = mrun; }
            mrun = mnew;
        }
        __syncthreads();
        if (c + 1 < NCH) P3M_PREFETCH(c + 1);
        { float kt[4];
#pragma unroll
          for (int e = 0; e < 4; ++e) { float acc = bcv[e];
#pragma unroll
              for (int j = 0; j < 4; ++j) acc += wcv[j][e] * kraw[(cs + j) * 33 + c4 * 4 + e];
              kt[e] = siluf_(acc) * 0.08838834764831845f; }
          const float w = wsL[cs];
#pragma unroll
          for (int e = 0; e < 4; ++e) ktw[cs * 33 + c4 * 4 + e] = kt[e] * w;
          u32x2 o; o.x = pk2(kt[0], kt[1]); o.y = pk2(kt[2], kt[3]);
          *(u32x2*)(KT + (size_t)(t0 + cs) * 512 + h * 128 + ks * 32 + c4 * 4) = o; }
        { bf16_t* dst = SM + ((size_t)(bh * 32 + c) * 128 + ks * 32 + ci) * 128 + 4 * jg;
          u32x2 o0, o1; o0.x = pk2(C[0], C[1]); o0.y = pk2(C[2], C[3]); o1.x = pk2(C[4], C[5]); o1.y = pk2(C[6], C[7]);
          *(u32x2*)(dst) = o0; *(u32x2*)(dst + 64) = o1;
          if (jg == 0) NST[(size_t)(bh * 32 + c) * 128 + ks * 32 + ci] = nacc; }
        __syncthreads();
        { const float dec = scl[0];
#pragma unroll
          for (int e = 0; e < 8; ++e) C[e] *= dec;
          nacc *= dec;
#pragma unroll 4
          for (int s = 0; s < 64; ++s) { const float kv = ktw[s * 33 + ci]; const f32x4 va = *(const LAS f32x4*)(vs + s * 128 + 4 * jg), vb = *(const LAS f32x4*)(vs + s * 128 + 64 + 4 * jg);
              C[0] += kv * va[0]; C[1] += kv * va[1]; C[2] += kv * va[2]; C[3] += kv * va[3]; C[4] += kv * vb[0]; C[5] += kv * vb[1]; C[6] += kv * vb[2]; C[7] += kv * vb[3]; nacc += kv; } }
        __syncthreads();
    }
#undef P3M_PREFETCH
}
__device__ __forceinline__ void p3_gla_item(Frame& F, const Args& args, int item) {
    const int ks = item & 3, bh = item >> 2, b = bh >> 2, h = bh & 3, tid = F.tid, lane = F.lane;
    LAS float* gaL = (LAS float*)F.lds;
    LAS float* kL = gaL + 64 * 17;
    LAS float* laL = kL + 64 * 17;
    LAS float* vs = laL + 64 * 17;
    LAS float* ecl = vs + 64 * 128;
    const bf16_t* proj = (const bf16_t*)(F.ws + WS_PROJ); const float* gates = (const float*)(F.ws + WS_GATES);
    bf16_t* SG = (bf16_t*)(F.ws + WS_SG);
    const int kcol = PC_GK + h * 64 + ks * 16, vcol = PC_GV + h * 128;
    const int ls = tid >> 3, lc = (tid & 7) * 2;
    float wa[2][16], ba[2];
#pragma unroll
    for (int e = 0; e < 2; ++e) { const int ch = h * 64 + ks * 16 + lc + e; ba[e] = args.in[11][ch];
#pragma unroll
        for (int r = 0; r < 16; ++r) wa[e][r] = args.in[10][r * 256 + ch]; }
    const int si = tid >> 5, jg = tid & 31;
    float S[4] = {0.f, 0.f, 0.f, 0.f};
    f32x2 pga; u32x2 pk; u32x4 pv[2];
#define P3G_PREFETCH(c_) do { const int t0_ = b * SEQ + (c_) * 64; \
        pga = *(const f32x2*)(gates + (size_t)(t0_ + (tid >> 3)) * 32 + 8 + (tid & 7) * 2); \
        pk = (u32x2){0u, 0u}; if (tid < 256) pk = *(const u32x2*)(proj + (size_t)(t0_ + (tid >> 2)) * NPROJ + kcol + (tid & 3) * 4); \
        _Pragma("unroll") for (int q_ = 0; q_ < 2; ++q_) { const int p_ = tid + 512 * q_; pv[q_] = *(const u32x4*)(proj + (size_t)(t0_ + (p_ >> 4)) * NPROJ + vcol + (p_ & 15) * 8); } } while (0)
    P3G_PREFETCH(0);
    for (int c = 0; c < NCH; ++c) {
        gaL[(tid >> 3) * 17 + (tid & 7) * 2] = pga[0]; gaL[(tid >> 3) * 17 + (tid & 7) * 2 + 1] = pga[1];
        if (tid < 256) { LAS float* d = kL + (tid >> 2) * 17 + (tid & 3) * 4; d[0] = bflo(pk.x); d[1] = bfhi(pk.x); d[2] = bflo(pk.y); d[3] = bfhi(pk.y); }
#pragma unroll
        for (int q = 0; q < 2; ++q) { const int p = tid + 512 * q; LAS float* d = vs + (p >> 4) * 128 + (p & 15) * 8;
            d[0] = bflo(pv[q].x); d[1] = bfhi(pv[q].x); d[2] = bflo(pv[q].y); d[3] = bfhi(pv[q].y); d[4] = bflo(pv[q].z); d[5] = bfhi(pv[q].z); d[6] = bflo(pv[q].w); d[7] = bfhi(pv[q].w); }
        __syncthreads();
        if (c + 1 < NCH) P3G_PREFETCH(c + 1);
#pragma unroll
        for (int e = 0; e < 2; ++e) { float acc = ba[e];
#pragma unroll
            for (int r = 0; r < 16; ++r) acc += gaL[ls * 17 + r] * wa[e][r];
            laL[ls * 17 + lc + e] = logsigf_(acc) * 0.0625f; }
        __syncthreads();
#pragma unroll
        for (int e = 0; e < 2; ++e) { const int ch = F.wave * 2 + e; const float x = laL[lane * 17 + ch]; const float cum = wave_scan_add(x, lane);
            laL[lane * 17 + ch] = kL[lane * 17 + ch] * __expf(-cum); if (lane == 63) ecl[ch] = __expf(cum); }
        { bf16_t* dst = SG + ((size_t)(bh * 32 + c) * 64 + ks * 16 + si) * 128 + 4 * jg; u32x2 o; o.x = pk2(S[0], S[1]); o.y = pk2(S[2], S[3]); *(u32x2*)dst = o; }
        __syncthreads();
        { float a0 = 0.f, a1 = 0.f, a2 = 0.f, a3 = 0.f;
#pragma unroll 4
          for (int s = 0; s < 64; ++s) { const float kv = laL[s * 17 + si]; const f32x4 v = *(const LAS f32x4*)(vs + s * 128 + 4 * jg); a0 += kv * v[0]; a1 += kv * v[1]; a2 += kv * v[2]; a3 += kv * v[3]; }
          const float ec = ecl[si]; S[0] = ec * (S[0] + a0); S[1] = ec * (S[1] + a1); S[2] = ec * (S[2] + a2); S[3] = ec * (S[3] + a3); }
        __syncthreads();
    }
#undef P3G_PREFETCH
}
__device__ __forceinline__ void p3_scan(Frame& F, const Args& args) {
    for (int it = F.vcu; it < 256; it += F.G) { if (it < 128) p3_mlstm_item(F, args, it); else p3_gla_item(F, args, it - 128); }
}

__device__ __forceinline__ void p4_mlstm_item(Frame& F, const Args& args, int item) {
    const int c = item & 31, bh = item >> 5, b = bh >> 2, h = bh & 3, tid = F.tid, lane = F.lane;
    const int t0 = b * SEQ + c * 64;
    LAS float* qs = (LAS float*)F.lds;
    LAS float* kc = qs + 64 * 129;
    LAS bf16_t* Cb = (LAS bf16_t*)kc;
    LAS float* vs = (LAS float*)((LAS unsigned char*)kc + 34816);
    LAS float* ps = vs + 64 * 128;
    LAS float* bvec = ps + 64 * 65;
    LAS float* avec = bvec + 64;
    LAS float* Mvec = avec + 64;
    LAS float* nvec = Mvec + 64;
    LAS float* qn = nvec + 128;
    const bf16_t* proj = (const bf16_t*)(F.ws + WS_PROJ); const bf16_t* KT = (const bf16_t*)(F.dob + DO_KT); const bf16_t* SM = (const bf16_t*)(F.ws + WS_SM);
    const float* GB = (const float*)(F.ws + WS_GB); const float* GA = (const float*)(F.ws + WS_GA); const float* MST = (const float*)(F.ws + WS_MST); const float* NST = (const float*)(F.ws + WS_NST);
    bf16_t* HC = (bf16_t*)(F.dob + DO_HCAT);
    const int t = tid >> 3, g8 = tid & 7;
    const float mc = MST[bh * 32 + c];
    { const int ch0 = g8 * 16;
      float acc[16];
#pragma unroll
      for (int e = 0; e < 16; ++e) acc[e] = args.in[6][h * 128 + ch0 + e];
#pragma unroll
      for (int j = 0; j < 4; ++j) { const int r = t - 3 + j;
          if (c > 0 || r >= 0) { const u32x4* src = (const u32x4*)(proj + (size_t)(t0 + r) * NPROJ + PC_MQ + h * 128 + ch0); const u32x4 w0 = src[0], w1 = src[1];
              const float* wc = args.in[5] + j * 1024 + h * 128 + ch0;
              acc[0] += wc[0] * bflo(w0.x); acc[1] += wc[1] * bfhi(w0.x); acc[2] += wc[2] * bflo(w0.y); acc[3] += wc[3] * bfhi(w0.y);
              acc[4] += wc[4] * bflo(w0.z); acc[5] += wc[5] * bfhi(w0.z); acc[6] += wc[6] * bflo(w0.w); acc[7] += wc[7] * bfhi(w0.w);
              acc[8] += wc[8] * bflo(w1.x); acc[9] += wc[9] * bfhi(w1.x); acc[10] += wc[10] * bflo(w1.y); acc[11] += wc[11] * bfhi(w1.y);
              acc[12] += wc[12] * bflo(w1.z); acc[13] += wc[13] * bfhi(w1.z); acc[14] += wc[14] * bflo(w1.w); acc[15] += wc[15] * bfhi(w1.w); } }
#pragma unroll
      for (int e = 0; e < 16; ++e) qs[t * 129 + ch0 + e] = siluf_(acc[e]);
      { const u32x4* src = (const u32x4*)(KT + (size_t)(t0 + t) * 512 + h * 128 + ch0); const u32x4 w0 = src[0], w1 = src[1]; LAS float* d = kc + t * 129 + ch0;
        d[0] = bflo(w0.x); d[1] = bfhi(w0.x); d[2] = bflo(w0.y); d[3] = bfhi(w0.y); d[4] = bflo(w0.z); d[5] = bfhi(w0.z); d[6] = bflo(w0.w); d[7] = bfhi(w0.w);
        d[8] = bflo(w1.x); d[9] = bfhi(w1.x); d[10] = bflo(w1.y); d[11] = bfhi(w1.y); d[12] = bflo(w1.z); d[13] = bfhi(w1.z); d[14] = bflo(w1.w); d[15] = bfhi(w1.w); }
      { const u32x4* src = (const u32x4*)(proj + (size_t)(t0 + t) * NPROJ + PC_MV + h * 128 + ch0); const u32x4 w0 = src[0], w1 = src[1]; LAS float* d = vs + t * 128 + ch0;
        d[0] = bflo(w0.x); d[1] = bfhi(w0.x); d[2] = bflo(w0.y); d[3] = bfhi(w0.y); d[4] = bflo(w0.z); d[5] = bfhi(w0.z); d[6] = bflo(w0.w); d[7] = bfhi(w0.w);
        d[8] = bflo(w1.x); d[9] = bfhi(w1.x); d[10] = bflo(w1.y); d[11] = bfhi(w1.y); d[12] = bflo(w1.z); d[13] = bfhi(w1.z); d[14] = bflo(w1.w); d[15] = bfhi(w1.w); } }
    if (tid < 64) { const float bv = GB[(size_t)(t0 + lane) * 4 + h], av = GA[(size_t)(t0 + lane) * 4 + h]; const float pm = wave_scan_max(av, lane);
        bvec[lane] = bv; avec[lane] = av; Mvec[lane] = fmaxf(pm, mc); }
    else if (tid < 192) nvec[tid - 64] = NST[(size_t)(bh * 32 + c) * 128 + (tid - 64)];
    __syncthreads();
    { float acc[8];
#pragma unroll
      for (int e = 0; e < 8; ++e) acc[e] = 0.f;
#pragma unroll 4
      for (int k = 0; k < 128; ++k) { const float qv = qs[t * 129 + k];
#pragma unroll
          for (int e = 0; e < 8; ++e) acc[e] += qv * kc[(g8 + 8 * e) * 129 + k]; }
      const float Mt = Mvec[t];
#pragma unroll
      for (int e = 0; e < 8; ++e) { const int s = g8 + 8 * e; ps[t * 65 + s] = (s <= t) ? acc[e] * __expf(avec[s] - Mt) : 0.f; }
      float pq = 0.f;
#pragma unroll
      for (int k = 0; k < 16; ++k) pq += qs[t * 129 + g8 * 16 + k] * nvec[g8 * 16 + k];
      pq += __shfl_xor(pq, 1); pq += __shfl_xor(pq, 2); pq += __shfl_xor(pq, 4);
      if (g8 == 0) qn[t] = pq; }
    __syncthreads();
#pragma unroll
    for (int q = 0; q < 4; ++q) { const int p = tid + 512 * q, i = p >> 4, c8 = (p & 15) * 8;
        *(LAS u32x4*)(Cb + i * 136 + c8) = *(const u32x4*)(SM + ((size_t)(bh * 32 + c) * 128 + i) * 128 + c8); }
    __syncthreads();
    { float num[16]; float den = 0.f;
#pragma unroll
      for (int e = 0; e < 16; ++e) num[e] = 0.f;
#pragma unroll 2
      for (int i = 0; i < 128; ++i) { const float qv = qs[t * 129 + i];
#pragma unroll
          for (int q = 0; q < 4; ++q) { const u32x2 w = *(const LAS u32x2*)(Cb + i * 136 + 32 * q + 4 * g8);
              num[q * 4 + 0] += qv * bflo(w.x); num[q * 4 + 1] += qv * bfhi(w.x); num[q * 4 + 2] += qv * bflo(w.y); num[q * 4 + 3] += qv * bfhi(w.y); } }
      const float Mt = Mvec[t], inter = __expf(mc - Mt);
#pragma unroll
      for (int e = 0; e < 16; ++e) num[e] *= inter;
#pragma unroll 2
      for (int s = 0; s < 64; ++s) { const float p = ps[t * 65 + s]; den += p;
#pragma unroll
          for (int q = 0; q < 4; ++q) { const f32x4 v = *(const LAS f32x4*)(vs + s * 128 + 32 * q + 4 * g8);
              num[q * 4 + 0] += p * v[0]; num[q * 4 + 1] += p * v[1]; num[q * 4 + 2] += p * v[2]; num[q * 4 + 3] += p * v[3]; } }
      den += inter * qn[t];
      const float dn = fmaxf(fabsf(den), __expf(-(bvec[t] + Mt))); const float inv = 1.0f / dn;
      float ss = 0.f;
#pragma unroll
      for (int q = 0; q < 4; ++q) { const u32x2 w = *(const u32x2*)(proj + (size_t)(t0 + t) * NPROJ + PC_MO + h * 128 + 32 * q + 4 * g8);
          num[q * 4 + 0] *= inv * sigmoidf_(bflo(w.x)); num[q * 4 + 1] *= inv * sigmoidf_(bfhi(w.x)); num[q * 4 + 2] *= inv * sigmoidf_(bflo(w.y)); num[q * 4 + 3] *= inv * sigmoidf_(bfhi(w.y)); }
#pragma unroll
      for (int e = 0; e < 16; ++e) ss += num[e] * num[e];
      ss += __shfl_xor(ss, 1); ss += __shfl_xor(ss, 2); ss += __shfl_xor(ss, 4);
      const float rstd = 1.0f / sqrtf(ss * (1.0f / 128.0f) + LN_EPS);
#pragma unroll
      for (int q = 0; q < 4; ++q) { const int col = h * 128 + 32 * q + 4 * g8; const f32x4 g = *(const f32x4*)(args.in[9] + col);
          u32x2 o; o.x = pk2(num[q * 4 + 0] * rstd * g[0], num[q * 4 + 1] * rstd * g[1]); o.y = pk2(num[q * 4 + 2] * rstd * g[2], num[q * 4 + 3] * rstd * g[3]);
          *(u32x2*)(HC + (size_t)(t0 + t) * D + col) = o; } }
    __syncthreads();
}
__device__ __forceinline__ void p4_gla_item(Frame& F, const Args& args, int item) {
    const int c = item & 31, bh = item >> 5, b = bh >> 2, h = bh & 3, tid = F.tid, lane = F.lane;
    const int t0 = b * SEQ + c * 64;
    LAS float* cum = (LAS float*)F.lds;
    LAS float* qh = cum + 64 * 65;
    LAS float* kh = qh + 64 * 65;
    LAS float* as_ = kh + 64 * 65;
    LAS float* vs = as_ + 64 * 65;
    LAS float* gaL = vs + 64 * 128;
    LAS bf16_t* Sb = (LAS bf16_t*)(gaL + 64 * 17 + 3);
    Sb = (LAS bf16_t*)((LAS unsigned char*)vs + 64 * 128 * 4 + 4368);
    const bf16_t* proj = (const bf16_t*)(F.ws + WS_PROJ); const float* gates = (const float*)(F.ws + WS_GATES); const bf16_t* SG = (const bf16_t*)(F.ws + WS_SG);
    bf16_t* HC = (bf16_t*)(F.dob + DO_HCAT);
    const int t = tid >> 3, g8 = tid & 7;
    { const f32x2 g = *(const f32x2*)(gates + (size_t)(t0 + t) * 32 + 8 + g8 * 2); gaL[t * 17 + g8 * 2] = g[0]; gaL[t * 17 + g8 * 2 + 1] = g[1]; }
    { const u32x4* src = (const u32x4*)(proj + (size_t)(t0 + t) * NPROJ + PC_GV + h * 128 + g8 * 16); const u32x4 w0 = src[0], w1 = src[1]; LAS float* d = vs + t * 128 + g8 * 16;
      d[0] = bflo(w0.x); d[1] = bfhi(w0.x); d[2] = bflo(w0.y); d[3] = bfhi(w0.y); d[4] = bflo(w0.z); d[5] = bfhi(w0.z); d[6] = bflo(w0.w); d[7] = bfhi(w0.w);
      d[8] = bflo(w1.x); d[9] = bfhi(w1.x); d[10] = bflo(w1.y); d[11] = bfhi(w1.y); d[12] = bflo(w1.z); d[13] = bfhi(w1.z); d[14] = bflo(w1.w); d[15] = bfhi(w1.w); }
#pragma unroll
    for (int q = 0; q < 2; ++q) { const int p = tid + 512 * q, i = p >> 4, c8 = (p & 15) * 8;
        *(LAS u32x4*)(Sb + i * 136 + c8) = *(const u32x4*)(SG + ((size_t)(bh * 32 + c) * 64 + i) * 128 + c8); }
    __syncthreads();
    { float acc[8];
#pragma unroll
      for (int e = 0; e < 8; ++e) acc[e] = args.in[11][h * 64 + g8 * 8 + e];
#pragma unroll
      for (int r = 0; r < 16; ++r) { const float gv = gaL[t * 17 + r]; const f32x4 w0 = *(const f32x4*)(args.in[10] + r * 256 + h * 64 + g8 * 8), w1 = *(const f32x4*)(args.in[10] + r * 256 + h * 64 + g8 * 8 + 4);
          acc[0] += gv * w0[0]; acc[1] += gv * w0[1]; acc[2] += gv * w0[2]; acc[3] += gv * w0[3]; acc[4] += gv * w1[0]; acc[5] += gv * w1[1]; acc[6] += gv * w1[2]; acc[7] += gv * w1[3]; }
#pragma unroll
      for (int e = 0; e < 8; ++e) cum[t * 65 + g8 * 8 + e] = logsigf_(acc[e]) * 0.0625f; }
    __syncthreads();
#pragma unroll
    for (int e = 0; e < 8; ++e) { const int ch = F.wave * 8 + e; const float x = cum[lane * 65 + ch]; cum[lane * 65 + ch] = wave_scan_add(x, lane); }
    __syncthreads();
    { const u32x4 wq = *(const u32x4*)(proj + (size_t)(t0 + t) * NPROJ + PC_GQ + h * 64 + g8 * 8), wk = *(const u32x4*)(proj + (size_t)(t0 + t) * NPROJ + PC_GK + h * 64 + g8 * 8);
      float qv[8] = {bflo(wq.x), bfhi(wq.x), bflo(wq.y), bfhi(wq.y), bflo(wq.z), bfhi(wq.z), bflo(wq.w), bfhi(wq.w)};
      float kv[8] = {bflo(wk.x), bfhi(wk.x), bflo(wk.y), bfhi(wk.y), bflo(wk.z), bfhi(wk.z), bflo(wk.w), bfhi(wk.w)};
#pragma unroll
      for (int e = 0; e < 8; ++e) { const float cu = cum[t * 65 + g8 * 8 + e]; qh[t * 65 + g8 * 8 + e] = qv[e] * 0.125f * __expf(cu); kh[t * 65 + g8 * 8 + e] = kv[e] * __expf(-cu); } }
    __syncthreads();
    { float acc[8];
#pragma unroll
      for (int e = 0; e < 8; ++e) acc[e] = 0.f;
#pragma unroll 4
      for (int k = 0; k < 64; ++k) { const float q = qh[t * 65 + k];
#pragma unroll
          for (int e = 0; e < 8; ++e) acc[e] += q * kh[(g8 + 8 * e) * 65 + k]; }
#pragma unroll
      for (int e = 0; e < 8; ++e) { const int s = g8 + 8 * e; as_[t * 65 + s] = (s <= t) ? acc[e] : 0.f; } }
    __syncthreads();
    { float o[16];
#pragma unroll
      for (int e = 0; e < 16; ++e) o[e] = 0.f;
#pragma unroll 2
      for (int s = 0; s < 64; ++s) { const float p = as_[t * 65 + s];
#pragma unroll
          for (int q = 0; q < 4; ++q) { const f32x4 v = *(const LAS f32x4*)(vs + s * 128 + 32 * q + 4 * g8);
              o[q * 4 + 0] += p * v[0]; o[q * 4 + 1] += p * v[1]; o[q * 4 + 2] += p * v[2]; o[q * 4 + 3] += p * v[3]; } }
#pragma unroll 2
      for (int k = 0; k < 64; ++k) { const float q_ = qh[t * 65 + k];
#pragma unroll
          for (int q = 0; q < 4; ++q) { const u32x2 w = *(const LAS u32x2*)(Sb + k * 136 + 32 * q + 4 * g8);
              o[q * 4 + 0] += q_ * bflo(w.x); o[q * 4 + 1] += q_ * bfhi(w.x); o[q * 4 + 2] += q_ * bflo(w.y); o[q * 4 + 3] += q_ * bfhi(w.y); } }
      float ss = 0.f;
#pragma unroll
      for (int e = 0; e < 16; ++e) ss += o[e] * o[e];
      ss += __shfl_xor(ss, 1); ss += __shfl_xor(ss, 2); ss += __shfl_xor(ss, 4);
      const float rstd = 1.0f / sqrtf(ss * (1.0f / 128.0f) + LN_EPS);
#pragma unroll
      for (int q = 0; q < 4; ++q) { const int col = h * 128 + 32 * q + 4 * g8; const f32x4 g = *(const f32x4*)(args.in[12] + col);
          const u32x2 w = *(const u32x2*)(proj + (size_t)(t0 + t) * NPROJ + PC_GG + col);
          u32x2 ov; ov.x = pk2(o[q * 4 + 0] * rstd * g[0] * siluf_(bflo(w.x)), o[q * 4 + 1] * rstd * g[1] * siluf_(bfhi(w.x)));
          ov.y = pk2(o[q * 4 + 2] * rstd * g[2] * siluf_(bflo(w.y)), o[q * 4 + 3] * rstd * g[3] * siluf_(bfhi(w.y)));
          *(u32x2*)(HC + (size_t)(t0 + t) * D + 512 + col) = ov; } }
    __syncthreads();
}
__device__ __forceinline__ void p4_chunks(Frame& F, const Args& args) {
    for (int it = F.vcu; it < 2048; it += F.G) { if (it < 1024) p4_mlstm_item(F, args, it); else p4_gla_item(F, args, it - 1024); }
}

__device__ __forceinline__ void p5b_ln_route(Frame& F, const Args& args) {
    LAS int* lcnt = (LAS int*)F.lds;
    LAS int* lbase = lcnt + 32;
    LAS int* rec_e = lbase + 32;
    LAS int* rec_rank = rec_e + 128;
    LAS int* rec_idx = rec_rank + 128;
    LAS float* rec_w = (LAS float*)(rec_idx + 128);
    const float* mod = (const float*)(F.ws + WS_MOD); const float* WRT = (const float*)(F.ws + WS_WRT);
    float* Y = (float*)(F.ws + WS_Y); bf16_t* U2 = (bf16_t*)(F.ws + WS_U2);
    int* list = (int*)(F.ws + WS_LIST); float* rtw = (float*)(F.ws + WS_RTW);
    const int lane = F.lane, tid = F.tid;
    for (int rb = F.vcu; rb < M / 64; rb += F.G) {
        if (tid < 32) lcnt[tid] = 0;
        __syncthreads();
        for (int q = 0; q < 8; ++q) {
            const int lr = F.wave * 8 + q, t = rb * 64 + lr, b = t >> 11;
            const float* mb = mod + b * 6144;
            f32x4 z[4]; float s = 0.f;
#pragma unroll
            for (int j = 0; j < 4; ++j) { const int k = 4 * lane + 256 * j; const f32x4 xv = *(const f32x4*)(args.in[0] + (size_t)t * D + k), yv = *(const f32x4*)(Y + (size_t)t * D + k), g1 = *(const f32x4*)(mb + 2048 + k);
                z[j] = xv * DN_ALPHA + (g1 + 1.0f) * yv; s += (z[j][0] + z[j][1]) + (z[j][2] + z[j][3]); }
            const float mean = wave_sum(s) * (1.0f / D); float s2 = 0.f;
#pragma unroll
            for (int j = 0; j < 4; ++j) { z[j] = z[j] - mean; s2 += (z[j][0] * z[j][0] + z[j][1] * z[j][1]) + (z[j][2] * z[j][2] + z[j][3] * z[j][3]); }
            const float rstd = 1.0f / sqrtf(wave_sum(s2) * (1.0f / D) + LN_EPS);
            f32x4 u2[4];
#pragma unroll
            for (int j = 0; j < 4; ++j) { const int k = 4 * lane + 256 * j; const f32x4 lg = *(const f32x4*)(args.in[14] + k), lb = *(const f32x4*)(args.in[15] + k);
                const f32x4 x1 = z[j] * rstd * lg + lb; *(f32x4*)(Y + (size_t)t * D + k) = x1;
                const f32x4 sc2 = *(const f32x4*)(mb + 4096 + k), sh2 = *(const f32x4*)(mb + 3072 + k);
                u2[j] = x1 * (sc2 + 1.0f) + sh2; u32x2 w; w.x = pk2(u2[j][0], u2[j][1]); w.y = pk2(u2[j][2], u2[j][3]); *(u32x2*)(U2 + (size_t)t * D + k) = w; }
            float mylogit = 0.f;
#pragma unroll 2
            for (int e = 0; e < 36; ++e) { float p = 0.f;
#pragma unroll
                for (int j = 0; j < 4; ++j) { const f32x4 w = *(const f32x4*)(WRT + e * 1024 + 4 * lane + 256 * j); p += (u2[j][0] * w[0] + u2[j][1] * w[1]) + (u2[j][2] * w[2] + u2[j][3] * w[3]); }
                p = wave_sum(p);
                if (lane == e) mylogit = p; }
            if (lane < 4) mylogit += args.in[17][lane]; else if (lane < 36) mylogit += args.in[19][lane - 4];
            float lg4[4];
#pragma unroll
            for (int i = 0; i < 4; ++i) lg4[i] = __shfl(mylogit, i);
            int gs = 0; float gm = lg4[0];
#pragma unroll
            for (int i = 1; i < 4; ++i) if (lg4[i] > gm) { gm = lg4[i]; gs = i; }
            float gsum = 0.f;
#pragma unroll
            for (int i = 0; i < 4; ++i) gsum += __expf(lg4[i] - gm);
            const float pg = 1.0f / gsum;
            float ein[8];
#pragma unroll
            for (int i = 0; i < 8; ++i) ein[i] = __shfl(mylogit, 4 + gs * 8 + i);
            int i1 = 0; float v1 = ein[0];
#pragma unroll
            for (int i = 1; i < 8; ++i) if (ein[i] > v1) { v1 = ein[i]; i1 = i; }
            int i2 = -1; float v2 = -3.0e38f;
#pragma unroll
            for (int i = 0; i < 8; ++i) if (i != i1 && ein[i] > v2) { v2 = ein[i]; i2 = i; }
            const float ex = __expf(v2 - v1); const float p1 = 1.0f / (1.0f + ex), p2 = ex * p1;
            if (lane == 0) {
                const int e1 = gs * 8 + i1, e2 = gs * 8 + i2;
                const int r1 = atomicAdd((int*)&lcnt[e1], 1), r2 = atomicAdd((int*)&lcnt[e2], 1);
                rec_e[lr * 2] = e1; rec_rank[lr * 2] = r1; rec_idx[lr * 2] = t * 2; rec_w[lr * 2] = pg * p1;
                rec_e[lr * 2 + 1] = e2; rec_rank[lr * 2 + 1] = r2; rec_idx[lr * 2 + 1] = t * 2 + 1; rec_w[lr * 2 + 1] = pg * p2;
            }
        }
        __syncthreads();
        if (tid < 32) { const int n = lcnt[tid]; lbase[tid] = n ? (int)__hip_atomic_fetch_add(F.ctl + CW_ECNT + 64 * tid, (unsigned)n, RLX_AGENT) : 0; }
        __syncthreads();
        if (tid < 128) { const int e = rec_e[tid], pos = lbase[e] + rec_rank[tid], idx = rec_idx[tid]; list[(size_t)e * LISTCAP + pos] = idx; rtw[idx] = rec_w[tid]; }
        __syncthreads();
    }
}
__device__ __forceinline__ void moe_tables(Frame& F) {
    LAS int* tab = (LAS int*)(F.lds + MOE_OFF);
    if (F.tid < 32) tab[66 + F.tid] = (int)__hip_atomic_load(F.ctl + CW_ECNT + 64 * F.tid, RLX_AGENT);
    __syncthreads();
    if (F.tid == 0) { int ts = 0, hr = 0; for (int e = 0; e < 32; ++e) { tab[e] = ts; tab[33 + e] = hr; const int nt = (tab[66 + e] + 255) >> 8; ts += nt; hr += nt * 256; } tab[32] = ts; tab[65] = hr; }
    __syncthreads();
}
__device__ __forceinline__ void p7_final(Frame& F, const Args& args) {
    const float* mod = (const float*)(F.ws + WS_MOD); const float* X1 = (const float*)(F.ws + WS_Y); const bf16_t* Y2 = (const bf16_t*)(F.dob + DO_Y2);
    const int gw = F.vcu * NWAVES + F.wave, NGW = F.G * NWAVES, lane = F.lane;
    for (int t = gw; t < M; t += NGW) {
        const int b = t >> 11; const float* mb = mod + b * 6144;
        f32x4 z[4]; float s = 0.f;
#pragma unroll
        for (int j = 0; j < 4; ++j) { const int k = 4 * lane + 256 * j; const f32x4 xv = *(const f32x4*)(X1 + (size_t)t * D + k), g2 = *(const f32x4*)(mb + 5120 + k);
            const u32x2 wa = *(const u32x2*)(Y2 + (size_t)(2 * t) * D + k), wb = *(const u32x2*)(Y2 + (size_t)(2 * t + 1) * D + k);
            const f32x4 yv = (f32x4){bflo(wa.x) + bflo(wb.x), bfhi(wa.x) + bfhi(wb.x), bflo(wa.y) + bflo(wb.y), bfhi(wa.y) + bfhi(wb.y)};
            z[j] = xv * DN_ALPHA + (g2 + 1.0f) * yv; s += (z[j][0] + z[j][1]) + (z[j][2] + z[j][3]); }
        const float mean = wave_sum(s) * (1.0f / D); float s2 = 0.f;
#pragma unroll
        for (int j = 0; j < 4; ++j) { z[j] = z[j] - mean; s2 += (z[j][0] * z[j][0] + z[j][1] * z[j][1]) + (z[j][2] * z[j][2] + z[j][3] * z[j][3]); }
        const float rstd = 1.0f / sqrtf(wave_sum(s2) * (1.0f / D) + LN_EPS);
#pragma unroll
        for (int j = 0; j < 4; ++j) { const int k = 4 * lane + 256 * j; const f32x4 lg = *(const f32x4*)(args.in[23] + k), lb = *(const f32x4*)(args.in[24] + k);
            *(f32x4*)(F.out + (size_t)t * D + k) = z[j] * rstd * lg + lb; }
    }
}

__global__ void __launch_bounds__(NT, 2) mega_fwd(Args args) {
    extern __shared__ __attribute__((aligned(16))) unsigned char lds_raw[];
    Frame F;
    F.lds = (LAS unsigned char*)lds_raw;
    F.tid = threadIdx.x; F.lane = F.tid & 63; F.wave = __builtin_amdgcn_readfirstlane(F.tid >> 6);
    F.G = gridDim.x; { const int bx = blockIdx.x; F.vcu = (F.G % 8 == 0) ? (bx % 8) * (F.G / 8) + bx / 8 : bx; }
    F.ws = args.ws; F.ctl = (unsigned*)(args.ws + WS_CTL); F.out = args.out; F.dob = (unsigned char*)args.out;
    for (int u = F.tid; u < (LDS_BYTES - LDSCTL_OFF) / 4; u += NT) ((LAS unsigned*)(F.lds + LDSCTL_OFF))[u] = 0u;
    __syncthreads();
    XcdBarrier bar = xcd_barrier_post(F.ctl + CW_BAR, (volatile LAS unsigned*)(F.lds + MISC_OFF) + 8);
#define GRID_BAR() xcd_barrier(bar)
#ifndef PH_MASK
#define PH_MASK 0xFFFF
#endif
    if (PH_MASK & 1) p0_prologue(F, args);
    GRID_BAR();
    if (PH_MASK & 2) p1_modulate(F, args);
    GRID_BAR();
    if (PH_MASK & 4) { pg8::DenseSched S; S.init(F.dob + DO_U, F.ws + WS_WIN, M, NPAD, D, F.G, (int)blockIdx.x);
      EpiProj E{(bf16_t*)(F.ws + WS_PROJ), (float*)(F.ws + WS_GATES)};
      pg8::gemm_phase<false, true>(F.lds, D, S, E); }
    GRID_BAR();
    if (PH_MASK & 8) p3_scan(F, args);
    GRID_BAR();
    if (PH_MASK & 16) p4_chunks(F, args);
    GRID_BAR();
    if (PH_MASK & 32) { pg8::DenseSched S; S.init(F.dob + DO_HCAT, F.ws + WS_WOUT, M, D, D, F.G, (int)blockIdx.x);
      EpiF32 E{(float*)(F.ws + WS_Y)};
      pg8::gemm_phase<false, true>(F.lds, D, S, E); }
    GRID_BAR();
    if (PH_MASK & 64) p5b_ln_route(F, args);
    GRID_BAR();
    moe_tables(F);
    if (PH_MASK & 128) { pg8::MoeSched S{(const char*)(F.ws + WS_U2), (const char*)(F.ws + WS_WGU), (size_t)1024 * 1024 * 2, D, (const LAS int*)(F.lds + MOE_OFF), (const int*)(F.ws + WS_LIST), F.G, (int)blockIdx.x, true};
      EpiHid E{(bf16_t*)(F.ws + WS_HID)};
      pg8::gemm_phase<true, true>(F.lds, D, S, E); }
    GRID_BAR();
    if (PH_MASK & 256) { pg8::MoeSched S{(const char*)(F.ws + WS_HID), (const char*)(F.ws + WS_WD), (size_t)1024 * 512 * 2, DEXP, (const LAS int*)(F.lds + MOE_OFF), (const int*)(F.ws + WS_LIST), F.G, (int)blockIdx.x, false};
      EpiY2 E{(bf16_t*)(F.dob + DO_Y2), (const float*)(F.ws + WS_RTW)};
      pg8::gemm_phase<false, true>(F.lds, DEXP, S, E); }
    GRID_BAR();
    if (PH_MASK & 512) p7_final(F, args);
}

extern "C" void kernel_launch(void* const* d_in, const int* in_sizes, int n_in, void* d_out, int out_size, void* d_ws, size_t ws_size, hipStream_t stream) {
    static int grid = 0;
    if (grid == 0) {
        if (n_in != 25 || out_size != M * D || ws_size < WS_END) { fprintf(stderr, "kernel_launch: unexpected problem (n_in %d out %d ws %zu)\n", n_in, out_size, ws_size); grid = -1; return; }
        int dev = 0, cus = 0;
        if (hipGetDevice(&dev) != hipSuccess || hipDeviceGetAttribute(&cus, hipDeviceAttributeMultiprocessorCount, dev) != hipSuccess) { grid = -1; return; }
        if (hipFuncSetAttribute((const void*)mega_fwd, hipFuncAttributeMaxDynamicSharedMemorySize, LDS_BYTES) != hipSuccess) { fprintf(stderr, "kernel_launch: hipFuncSetAttribute failed\n"); grid = -1; return; }
        int per_cu = 0;
        (void)hipOccupancyMaxActiveBlocksPerMultiprocessor(&per_cu, (const void*)mega_fwd, NT, LDS_BYTES);
        (void)hipGetLastError();
        if (per_cu < 1) fprintf(stderr, "kernel_launch: occupancy query says %d\n", per_cu);
        grid = cus;
    }
    if (grid < 0) return;
    (void)hipMemsetAsync((char*)d_ws + WS_CTL, 0, CTL_ZERO_BYTES, stream);
    Args a{};
    for (int i = 0; i < 25; ++i) a.in[i] = (const float*)d_in[i];
    a.out = (float*)d_out; a.ws = (unsigned char*)d_ws;
    hipLaunchKernelGGL(mega_fwd, dim3(grid), dim3(NT), LDS_BYTES, stream, a);
}
```

```cpp
#include <hip/hip_runtime.h>
#include <cstdio>
#include <cstdint>

#define GAS __attribute__((address_space(1)))
#define LAS __attribute__((address_space(3)))
typedef unsigned short bf16_t;
typedef short bf16x8 __attribute__((ext_vector_type(8)));
typedef float f32x4 __attribute__((ext_vector_type(4)));
typedef float f32x2 __attribute__((ext_vector_type(2)));
typedef unsigned u32x4 __attribute__((ext_vector_type(4)));
typedef unsigned u32x2 __attribute__((ext_vector_type(2)));

constexpr int D = 1024, BATCH = 8, SEQ = 2048, M = BATCH * SEQ;
constexpr int INW = 3608, NPROJ = 3584, NPAD = 3840;
constexpr int NCH = SEQ / 64;
constexpr int NEXP = 32, DEXP = 512, LISTCAP = 16384;
constexpr float LN_EPS = 1e-5f;
constexpr float DN_ALPHA = 1.189207115002721f;
constexpr int PC_MQ = 0, PC_MK = 512, PC_MV = 1024, PC_MO = 1536, PC_GQ = 2048, PC_GK = 2304, PC_GV = 2560, PC_GG = 3072;

constexpr size_t MiB = 1u << 20;
constexpr size_t WS_CTL = 0, CTL_ZERO_BYTES = 1 * MiB;
constexpr size_t WS_MOD = 1 * MiB;
constexpr size_t WS_WRT = 1 * MiB + 512 * 1024;
constexpr size_t WS_RTW = 2 * MiB;
constexpr size_t WS_GB = 2 * MiB + 256 * 1024;
constexpr size_t WS_GA = 2 * MiB + 512 * 1024;
constexpr size_t WS_MST = 2 * MiB + 768 * 1024;
constexpr size_t WS_GPM = 1 * MiB + 768 * 1024;
constexpr size_t WS_NST = 3 * MiB;
constexpr size_t WS_LIST = 4 * MiB;
constexpr size_t WS_GATES = 6 * MiB;
constexpr size_t WS_WIN = 8 * MiB;
constexpr size_t WS_WOUT = 16 * MiB;
constexpr size_t WS_WGU = 18 * MiB;
constexpr size_t WS_WD = 82 * MiB;
constexpr size_t WS_SM = 114 * MiB;
constexpr size_t WS_SG = 146 * MiB;
constexpr size_t WS_HID = 114 * MiB;
constexpr size_t WS_PROJ = 162 * MiB;
constexpr size_t WS_Y = 162 * MiB;
constexpr size_t WS_U2 = 226 * MiB;
constexpr size_t WS_END = 274 * MiB;
constexpr size_t DO_U = 0, DO_VTM = 0, DO_VTG = 16 * MiB, DO_HCAT = 32 * MiB, DO_Y2 = 0;

constexpr int CW_TMO = 0;
constexpr int CW_BAR = 4096;
constexpr int CW_ECNT = 16384;
constexpr int CW_DBG = 32768;

constexpr int RING_BYTES = 131072;
constexpr int LDSCTL_OFF = RING_BYTES, MISC_OFF = LDSCTL_OFF + 320;
constexpr int MOE_OFF = LDSCTL_OFF + 1024;
constexpr int LDS_BYTES = 147456;
constexpr int NWAVES = 8, NT = 512;

#define RLX_AGENT __ATOMIC_RELAXED, __HIP_MEMORY_SCOPE_AGENT
#define LDS_WAIT() asm volatile("s_waitcnt lgkmcnt(0)" ::: "memory")
#define VM_WAIT() asm volatile("s_waitcnt vmcnt(0)" ::: "memory")

__device__ __forceinline__ unsigned f2bf(float f) { unsigned u = __builtin_bit_cast(unsigned, f); return (u + 0x7fffu + ((u >> 16) & 1u)) >> 16; }
__device__ __forceinline__ unsigned pk2(float lo, float hi) { return f2bf(lo) | (f2bf(hi) << 16); }
__device__ __forceinline__ float bf2f(unsigned short h) { return __builtin_bit_cast(float, (unsigned)h << 16); }
__device__ __forceinline__ float bflo(unsigned w) { return __builtin_bit_cast(float, w << 16); }
__device__ __forceinline__ float bfhi(unsigned w) { return __builtin_bit_cast(float, w & 0xffff0000u); }
__device__ __forceinline__ float sigmoidf_(float x) { return 1.0f / (1.0f + __expf(-x)); }
__device__ __forceinline__ float siluf_(float x) { return x / (1.0f + __expf(-x)); }
__device__ __forceinline__ float logsigf_(float x) { return fminf(x, 0.0f) - log1pf(__expf(-fabsf(x))); }
__device__ __forceinline__ float wave_sum(float v) {
#pragma unroll
    for (int o = 1; o < 64; o <<= 1) v += __shfl_xor(v, o);
    return v;
}
__device__ __forceinline__ float wave_max(float v) {
#pragma unroll
    for (int o = 1; o < 64; o <<= 1) v = fmaxf(v, __shfl_xor(v, o));
    return v;
}
__device__ __forceinline__ float wave_scan_add(float v, int lane) {
#pragma unroll
    for (int o = 1; o < 64; o <<= 1) { float t = __shfl_up(v, o); if (lane >= o) v += t; }
    return v;
}
__device__ __forceinline__ float wave_scan_max(float v, int lane) {
#pragma unroll
    for (int o = 1; o < 64; o <<= 1) { float t = __shfl_up(v, o); if (lane >= o) v = fmaxf(v, t); }
    return v;
}

#define XB_TMO      128
#define XB_XCNT(j)  (256  + 64 * (j))
#define XB_XSUB(j)  (1280 + 64 * (j))
#define XB_XGEN(j)  (2304 + 64 * (j))
#define XB_TOP      3328
#define XB_TOPGEN   3392
#define XCD_BAR_WORDS 3456
#define XB_SPIN_CAP (1u << 18)
__device__ __forceinline__ unsigned xb_ld(unsigned* p)              { return __hip_atomic_load(p, __ATOMIC_RELAXED, __HIP_MEMORY_SCOPE_AGENT); }
__device__ __forceinline__ unsigned xb_add(unsigned* p, unsigned v) { return __hip_atomic_fetch_add(p, v, __ATOMIC_RELAXED, __HIP_MEMORY_SCOPE_AGENT); }
__device__ __forceinline__ unsigned xb_xcc_id() { return (unsigned)__builtin_amdgcn_s_getreg((3 << 11) | 20) & 0xFu; }
#define XB_SPIN(cond, bar) do { unsigned _sp = 0; while (cond) { __builtin_amdgcn_s_sleep(1); \
    if ((++_sp & 255u) == 0u) { if (xb_ld(&(bar)[XB_TMO])) break; if (_sp > XB_SPIN_CAP) { atomicAdd(&(bar)[XB_TMO], 1u); break; } } } } while (0)
struct XcdBarrier { unsigned* bar; unsigned x; volatile LAS unsigned* st; };
__device__ __forceinline__ XcdBarrier xcd_barrier_post(unsigned* bar, volatile LAS unsigned* st) {
    XcdBarrier b; b.bar = bar; b.x = xb_xcc_id(); b.st = st;
    if (threadIdx.x == 0) (void)xb_add(&bar[XB_XCNT(b.x)], 1u);
    return b;
}
__device__ __forceinline__ void xcd_barrier_complete(unsigned* bar, unsigned x, unsigned& nloc, unsigned& nx) {
    const unsigned G = gridDim.x * gridDim.y * gridDim.z;
    unsigned sum, cnt, mine, sp = 0u;
    for (;;) {
        sum = 0u; cnt = 0u; mine = 0u;
#pragma unroll
        for (unsigned j = 0; j < 16; ++j) { const unsigned c = xb_ld(&bar[XB_XCNT(j)]); sum += c; cnt += (c > 0u) ? 1u : 0u; mine = (j == x) ? c : mine; }
        if (sum == G) break;
        __builtin_amdgcn_s_sleep(1);
        if ((++sp & 255u) == 0u) { if (xb_ld(&bar[XB_TMO])) break; if (sp > XB_SPIN_CAP) { atomicAdd(&bar[XB_TMO], 1u); break; } }
    }
    nloc = mine > 0u ? mine : 1u; nx = cnt > 0u ? cnt : 1u;
}
__device__ __forceinline__ void xcd_barrier(const XcdBarrier& b) {
    asm volatile("s_waitcnt vmcnt(0)" ::: "memory");
    __syncthreads();
    if (threadIdx.x == 0) {
        unsigned* bar = b.bar;
        __builtin_amdgcn_s_waitcnt(0);
        unsigned nloc = b.st[0], nx = b.st[1];
        if (nloc == 0u) { xcd_barrier_complete(bar, b.x, nloc, nx); b.st[0] = nloc; b.st[1] = nx; }
        const unsigned old = xb_add(&bar[XB_XSUB(b.x)], 1u);
        const unsigned gen = old / nloc;
        if (old + 1u == (gen + 1u) * nloc) {
            __builtin_amdgcn_fence(__ATOMIC_RELEASE, "agent");
            asm volatile("s_waitcnt vmcnt(0)" ::: "memory");
            const unsigned og = xb_add(&bar[XB_TOP], 1u);
            const unsigned tg = og / nx;
            if (og + 1u == (tg + 1u) * nx) xb_add(&bar[XB_TOPGEN], 1u);
            else XB_SPIN(xb_ld(&bar[XB_TOPGEN]) == tg, bar);
            __builtin_amdgcn_fence(__ATOMIC_ACQUIRE, "agent");
            xb_add(&bar[XB_XGEN(b.x)], 1u);
            asm volatile("s_waitcnt vmcnt(0)" ::: "memory");
        } else {
            XB_SPIN(xb_ld(&bar[XB_XGEN(b.x)]) == gen, bar);
            __builtin_amdgcn_fence(__ATOMIC_ACQUIRE, "agent");
            asm volatile("s_waitcnt vmcnt(0)" ::: "memory");
        }
    }
    __syncthreads();
}

namespace pg8 {
constexpr int BM = 256, BK = 64, HALF = 128, HTB = HALF * BK * 2, STAGE_BYTES = 8 * HTB, NXCD = 8, WGM = 8;
__host__ __device__ __forceinline__ int lds_byte(int r, int c) { const int st = (r >> 4) * 2 + (c >> 5), rr = r & 15, cc = c & 31, ob = rr * 64 + cc * 2; return st * 1024 + (ob ^ (((ob >> 9) & 1) << 5)); }
__host__ __device__ __forceinline__ void stage_rc(int b, int& R, int& C) { const int st = b / 1024, sb = b % 1024, swz = sb ^ (((sb >> 9) & 1) << 5); R = (st >> 1) * 16 + swz / 64; C = (st & 1) * 32 + (swz % 64) / 2; }
__host__ __device__ __forceinline__ int perm32(int rho) { const int n = rho >> 4, i = rho & 15; return 8 * (i >> 2) + 4 * n + (i & 3); }
__device__ __forceinline__ unsigned cvt_pk_bf16(float lo, float hi) { unsigned r; asm volatile("v_cvt_pk_bf16_f32 %0, %1, %2" : "=v"(r) : "v"(lo), "v"(hi)); return r; }

struct GUnit { const char* A; const char* B; const int* rows; int nvalid, pm, pn, e, orow0; };

struct DenseSched {
    const char* A; const char* Bt; int K, nM, nN, nwg, G, c;
    __device__ void init(const void* A_, const void* Bt_, int M_, int N_, int K_, int G_, int c_) { A = (const char*)A_; Bt = (const char*)Bt_; K = K_; nM = M_ / BM; nN = N_ / BM; nwg = nM * nN; G = G_; c = c_; }
    __device__ bool next(int i, GUnit& u) const {
        const long L = (long)i * G + c; if (L >= nwg) return false;
        int wgid = (int)L; { const int q = nwg / NXCD, r = nwg % NXCD, xcd = wgid % NXCD, off = wgid / NXCD; wgid = (xcd < r ? xcd * (q + 1) : r * (q + 1) + (xcd - r) * q) + off; }
        const int nig = WGM * nN, gid = wgid / nig, fm = gid * WGM, gsz = (nM - fm) < WGM ? (nM - fm) : WGM;
        u.pm = fm + ((wgid % nig) % gsz); u.pn = (wgid % nig) / gsz;
        u.A = A + (size_t)u.pm * BM * K * 2; u.B = Bt + (size_t)u.pn * BM * K * 2; u.rows = nullptr; u.nvalid = BM; u.e = 0; u.orow0 = u.pm * BM;
        return true;
    }
};
struct MoeSched {
    const char* A; const char* Bt; size_t bstride; int K; const LAS int* tab; const int* list; int G, c; bool gather;
    __device__ bool next(int i, GUnit& u) const {
        const int nrt = tab[32], nwg = nrt * 4;
        const long L = (long)i * G + c; if (L >= nwg) return false;
        int wgid = (int)L; { const int q = nwg / NXCD, r = nwg % NXCD, xcd = wgid % NXCD, off = wgid / NXCD; wgid = (xcd < r ? xcd * (q + 1) : r * (q + 1) + (xcd - r) * q) + off; }
        const int rt = wgid >> 2; u.pn = wgid & 3;
        int e = 0;
        for (int j = 1; j < 32; ++j) if (tab[j] <= rt) e = j;
        const int mt = rt - tab[e];
        u.e = e; u.pm = mt; const int left = tab[66 + e] - BM * mt; u.nvalid = left < BM ? left : BM;
        u.rows = list + (size_t)e * LISTCAP + BM * mt; u.orow0 = tab[33 + e] + BM * mt;
        u.A = gather ? A : A + (size_t)u.orow0 * K * 2; u.B = Bt + (size_t)e * bstride + (size_t)u.pn * BM * K * 2;
        return true;
    }
};

template <bool GATHER, bool ALIGN_EPI, class Epi, class Sched>
__device__ __forceinline__ void gemm_phase(LAS unsigned char* lds, const int K, const Sched& S, const Epi& E) {
    int tid_ = threadIdx.x; asm volatile("" : "+v"(tid_));
    const int tid = tid_, wid = __builtin_amdgcn_readfirstlane(tid >> 6), lane = tid & 63, wr = wid >> 2, wc = wid & 3, fr = lane & 15, fq = lane >> 4;
    const int nt = K / BK;
    unsigned voffB[2];
#pragma unroll
    for (int i = 0; i < 2; ++i) { int R, C; stage_rc(tid * 16 + i * 8192, R, C); const int Rb = Epi::PERM ? ((R & ~31) + perm32(R & 31)) : R; voffB[i] = (unsigned)(Rb * K + C) * 2u; }
    const size_t kstep = (size_t)(BK * 2);
    const size_t hstep = (size_t)HALF * K * 2;
    const unsigned ldsw = (unsigned)wid * 1024u;
    const int aoff = lds_byte(wr * 64 + fr, fq * 8), boff = lds_byte(wc * 32 + fr, fq * 8);
#define PG8_SA(b, h) (((b) * 2 + (h)) * HTB)
#define PG8_SB(b, h) ((4 + (b) * 2 + (h)) * HTB)
#define PG8_STAGE(bufoff, gbase, voff) do { _Pragma("unroll") for (int _i = 0; _i < 2; ++_i) \
        __builtin_amdgcn_global_load_lds((const unsigned*)((const char*)(gbase) + (voff)[_i]), (LAS unsigned*)(lds + (bufoff) + ldsw + _i * 8192), 16, 0, 0); } while (0)
#define PG8_LDA(dst, b, h) do { _Pragma("unroll") for (int m = 0; m < 4; ++m) _Pragma("unroll") for (int k = 0; k < 2; ++k) dst[m][k] = *(const LAS bf16x8*)(lds + PG8_SA(b, h) + aoff + m * 2048 + k * 1024); } while (0)
#define PG8_LDB(dst, b, h) do { _Pragma("unroll") for (int n = 0; n < 2; ++n) _Pragma("unroll") for (int k = 0; k < 2; ++k) dst[n][k] = *(const LAS bf16x8*)(lds + PG8_SB(b, h) + boff + n * 2048 + k * 1024); } while (0)
#define PG8_MMA(ai, bj, At, Bt) do { __builtin_amdgcn_s_setprio(1); _Pragma("unroll") for (int m = 0; m < 4; ++m) _Pragma("unroll") for (int n = 0; n < 2; ++n) _Pragma("unroll") for (int k = 0; k < 2; ++k) \
        acc[ai][bj][m][n] = __builtin_amdgcn_mfma_f32_16x16x32_bf16(Bt[n][k], At[m][k], acc[ai][bj][m][n], 0, 0, 0); __builtin_amdgcn_s_setprio(0); } while (0)
#define PG8_WAIT_V(n) asm volatile("s_waitcnt vmcnt(" #n ")" ::: "memory")
#define PG8_WAIT_L(n) asm volatile("s_waitcnt lgkmcnt(" #n ")" ::: "memory")
#define PG8_BAR __builtin_amdgcn_s_barrier()
#define PG8_SCHED __builtin_amdgcn_sched_barrier(0)
#define PG8_MKVA(u, v0, v1) do { _Pragma("unroll") for (int _i = 0; _i < 2; ++_i) { int _R, _C; stage_rc(tid * 16 + _i * 8192, _R, _C); \
        if (GATHER) { const int _r0 = _R, _r1 = HALF + _R; const int _id0 = _r0 < (u).nvalid ? (u).rows[_r0] : 0; const int _id1 = _r1 < (u).nvalid ? (u).rows[_r1] : 0; \
            v0[_i] = (unsigned)((_id0 >> 1) * K + _C) * 2u; v1[_i] = (unsigned)((_id1 >> 1) * K + _C) * 2u; } \
        else { v0[_i] = (unsigned)(_R * K + _C) * 2u; v1[_i] = v0[_i] + (unsigned)hstep; } } } while (0)
    GUnit cur, nxt; int ui = 0;
    if (!S.next(0, cur)) return;
    f32x4 acc[2][2][4][2];
#pragma unroll
    for (int a = 0; a < 2; ++a)
#pragma unroll
        for (int b = 0; b < 2; ++b)
#pragma unroll
            for (int m = 0; m < 4; ++m)
#pragma unroll
                for (int n = 0; n < 2; ++n) acc[a][b][m][n] = (f32x4){0.f, 0.f, 0.f, 0.f};
    bf16x8 At[4][2], B0[2][2], B1[2][2];
    unsigned cva0[2], cva1[2];
    const char* cA = cur.A; const char* cB = cur.B;
    PG8_MKVA(cur, cva0, cva1);
    PG8_STAGE(PG8_SB(0, 0), cB, voffB); PG8_STAGE(PG8_SB(0, 1), cB + hstep, voffB); PG8_STAGE(PG8_SA(0, 0), cA, cva0); PG8_STAGE(PG8_SA(0, 1), cA, cva1);
    if (wr == 1) PG8_BAR;
    PG8_WAIT_V(2); PG8_BAR;
    PG8_STAGE(PG8_SB(1, 0), cB + kstep, voffB); PG8_STAGE(PG8_SA(1, 0), cA + kstep, cva0); PG8_STAGE(PG8_SB(1, 1), cB + hstep + kstep, voffB);
    PG8_WAIT_V(6); PG8_BAR;
    for (;;) {
        const bool has_next = S.next(ui + 1, nxt);
        const char* nA = has_next ? nxt.A : cA; const char* nB = has_next ? nxt.B : cB;
        for (int t = 0; t < nt; t += 2) {
            const bool last = (t == nt - 2);
            const char* a1 = cA + (size_t)(t + 1) * kstep;
            const char* a2 = last ? nA : cA + (size_t)(t + 2) * kstep; const char* b2 = last ? nB : cB + (size_t)(t + 2) * kstep;
            const char* a3 = a2 + kstep; const char* b3 = b2 + kstep;
            PG8_LDB(B0, 0, 0); PG8_LDB(B1, 0, 1); PG8_SCHED; PG8_LDA(At, 0, 0); PG8_STAGE(PG8_SA(1, 1), a1, cva1);
            PG8_WAIT_V(8); PG8_WAIT_L(0); PG8_BAR; PG8_MMA(0, 0, At, B0); PG8_MMA(0, 1, At, B1); PG8_BAR; PG8_SCHED;
            if (GATHER) { if (last && has_next) PG8_MKVA(nxt, cva0, cva1); }
            PG8_LDA(At, 0, 1); PG8_STAGE(PG8_SB(0, 0), b2, voffB); PG8_STAGE(PG8_SB(0, 1), b2 + hstep, voffB); PG8_STAGE(PG8_SA(0, 0), a2, cva0);
            PG8_WAIT_V(8); PG8_WAIT_L(0); PG8_BAR; PG8_MMA(1, 0, At, B0); PG8_MMA(1, 1, At, B1); PG8_BAR; PG8_SCHED;
            PG8_LDB(B0, 1, 0); PG8_LDB(B1, 1, 1); PG8_SCHED; PG8_LDA(At, 1, 0); PG8_STAGE(PG8_SA(0, 1), a2, cva1);
            PG8_WAIT_V(8); PG8_WAIT_L(0); PG8_BAR; PG8_MMA(0, 0, At, B0); PG8_MMA(0, 1, At, B1); PG8_BAR; PG8_SCHED;
            PG8_LDA(At, 1, 1); PG8_STAGE(PG8_SB(1, 0), b3, voffB); PG8_STAGE(PG8_SB(1, 1), b3 + hstep, voffB); PG8_STAGE(PG8_SA(1, 0), a3, cva0);
            PG8_WAIT_V(8); PG8_WAIT_L(0); PG8_BAR; PG8_MMA(1, 0, At, B0); PG8_MMA(1, 1, At, B1); PG8_BAR; PG8_SCHED;
        }
        if constexpr (ALIGN_EPI) { if (wr == 0) PG8_BAR; }
        E(acc, cur, wr, wc, fr, fq);
        if (!has_next) break;
#pragma unroll
        for (int a = 0; a < 2; ++a)
#pragma unroll
            for (int b = 0; b < 2; ++b)
#pragma unroll
                for (int m = 0; m < 4; ++m)
#pragma unroll
                    for (int n = 0; n < 2; ++n) acc[a][b][m][n] = (f32x4){0.f, 0.f, 0.f, 0.f};
        cur = nxt; cA = nA; cB = nB; ++ui;
        if constexpr (ALIGN_EPI) { if (wr == 1) PG8_BAR; }
    }
    PG8_WAIT_V(0);
    if constexpr (!ALIGN_EPI) { if (wr == 0) PG8_BAR; }
    PG8_BAR;
#undef PG8_SA
#undef PG8_SB
#undef PG8_STAGE
#undef PG8_LDA
#undef PG8_LDB
#undef PG8_MMA
#undef PG8_WAIT_V
#undef PG8_WAIT_L
#undef PG8_BAR
#undef PG8_SCHED
#undef PG8_MKVA
}
}

struct Args { const float* in[25]; float* out; unsigned char* ws; };
struct Frame {
    LAS unsigned char* lds;
    unsigned* ctl;
    int tid, lane, wave, vcu, G;
    float* out; unsigned char* ws; unsigned char* dob;
};

using pg8::GUnit; using pg8::cvt_pk_bf16;
struct EpiProj {
    static constexpr bool PERM = true;
    bf16_t* proj; float* gates;
    __device__ __forceinline__ void operator()(const f32x4 (&acc)[2][2][4][2], const GUnit& u, int wr, int wc, int fr, int fq) const {
        const int row0 = u.pm * 256 + wr * 64 + fr;
        if (u.pn < 14) {
            const int col0 = u.pn * 256 + wc * 32 + 8 * fq;
#pragma unroll
            for (int ai = 0; ai < 2; ++ai)
#pragma unroll
                for (int m = 0; m < 4; ++m) { bf16_t* rowp = proj + (size_t)(row0 + ai * 128 + m * 16) * NPROJ + col0;
#pragma unroll
                    for (int bj = 0; bj < 2; ++bj) { const f32x4 v0 = acc[ai][bj][m][0], v1 = acc[ai][bj][m][1];
                        u32x4 w; w.x = cvt_pk_bf16(v0[0], v0[1]); w.y = cvt_pk_bf16(v0[2], v0[3]); w.z = cvt_pk_bf16(v1[0], v1[1]); w.w = cvt_pk_bf16(v1[2], v1[3]);
                        *(u32x4*)(rowp + bj * 128) = w; } }
        } else if (wc == 0) {
#pragma unroll
            for (int ai = 0; ai < 2; ++ai)
#pragma unroll
                for (int m = 0; m < 4; ++m) { float* g = gates + (size_t)(row0 + ai * 128 + m * 16) * 32 + 8 * fq;
                    *(f32x4*)(g) = acc[ai][0][m][0]; *(f32x4*)(g + 4) = acc[ai][0][m][1]; }
        }
    }
};
struct EpiF32 {
    static constexpr bool PERM = false;
    float* C;
    __device__ __forceinline__ void operator()(const f32x4 (&acc)[2][2][4][2], const GUnit& u, int wr, int wc, int fr, int fq) const {
        const int row0 = u.pm * 256 + wr * 64 + fr, col0 = u.pn * 256 + wc * 32 + 4 * fq;
#pragma unroll
        for (int ai = 0; ai < 2; ++ai)
#pragma unroll
            for (int m = 0; m < 4; ++m) { float* rowp = C + (size_t)(row0 + ai * 128 + m * 16) * D + col0;
#pragma unroll
                for (int bj = 0; bj < 2; ++bj)
#pragma unroll
                    for (int n = 0; n < 2; ++n) *(f32x4*)(rowp + bj * 128 + n * 16) = acc[ai][bj][m][n]; }
    }
};
struct EpiHid {
    static constexpr bool PERM = true;
    bf16_t* hid;
    __device__ __forceinline__ void operator()(const f32x4 (&acc)[2][2][4][2], const GUnit& u, int wr, int wc, int fr, int fq) const {
        const int row0 = u.orow0 + wr * 64 + fr, col0 = u.pn * 128 + wc * 32 + 8 * fq;
#pragma unroll
        for (int ai = 0; ai < 2; ++ai)
#pragma unroll
            for (int m = 0; m < 4; ++m) { bf16_t* rowp = hid + (size_t)(row0 + ai * 128 + m * 16) * DEXP + col0;
                float h[8];
#pragma unroll
                for (int n = 0; n < 2; ++n)
#pragma unroll
                    for (int i = 0; i < 4; ++i) { const float g = acc[ai][0][m][n][i], up = acc[ai][1][m][n][i]; h[n * 4 + i] = siluf_(g) * up; }
                u32x4 w; w.x = cvt_pk_bf16(h[0], h[1]); w.y = cvt_pk_bf16(h[2], h[3]); w.z = cvt_pk_bf16(h[4], h[5]); w.w = cvt_pk_bf16(h[6], h[7]);
                *(u32x4*)(rowp) = w; }
    }
};
struct EpiY2 {
    static constexpr bool PERM = true;
    bf16_t* y2; const float* rtw;
    __device__ __forceinline__ void operator()(const f32x4 (&acc)[2][2][4][2], const GUnit& u, int wr, int wc, int fr, int fq) const {
        const int col0 = u.pn * 256 + wc * 32 + 8 * fq;
#pragma unroll
        for (int ai = 0; ai < 2; ++ai)
#pragma unroll
            for (int m = 0; m < 4; ++m) { const int r = ai * 128 + wr * 64 + m * 16 + fr;
                if (r < u.nvalid) { const int idx = u.rows[r]; const float wgt = rtw[idx]; bf16_t* rowp = y2 + (size_t)idx * D + col0;
#pragma unroll
                    for (int bj = 0; bj < 2; ++bj) { const f32x4 v0 = acc[ai][bj][m][0] * wgt, v1 = acc[ai][bj][m][1] * wgt;
                        u32x4 w; w.x = cvt_pk_bf16(v0[0], v0[1]); w.y = cvt_pk_bf16(v0[2], v0[3]); w.z = cvt_pk_bf16(v1[0], v1[1]); w.w = cvt_pk_bf16(v1[2], v1[3]);
                        *(u32x4*)(rowp + bj * 128) = w; } } }
    }
};

template <class ColFn>
__device__ __forceinline__ void transpose_item(const float* W, int ldw, int K, bf16_t* WT, int k0, LAS float* scr, int lane, ColFn colfn) {
    const int col = colfn(lane & 31);
#pragma unroll 8
    for (int i = 0; i < 32; ++i) { const int kk = 2 * i + (lane >> 5); scr[kk * 33 + (lane & 31)] = col >= 0 ? W[(size_t)(k0 + kk) * ldw + col] : 0.f; }
    LDS_WAIT(); asm volatile("" ::: "memory");
    const int c = lane & 7;
#pragma unroll
    for (int j = 0; j < 4; ++j) { const int n = (lane >> 3) + 8 * j; const LAS float* s = scr + (8 * c) * 33 + n;
        u32x4 o; o.x = pk2(s[0 * 33], s[1 * 33]); o.y = pk2(s[2 * 33], s[3 * 33]); o.z = pk2(s[4 * 33], s[5 * 33]); o.w = pk2(s[6 * 33], s[7 * 33]);
        *(u32x4*)(WT + (size_t)n * K + k0 + 8 * c) = o; }
    LDS_WAIT(); asm volatile("" ::: "memory");
}
__device__ __forceinline__ int win_orig_col(int np) {
    if (np < 2048) return np;
    if (np < 3584) return np + 8;
    if (np < 3592) return 2048 + (np - 3584);
    if (np < 3608) return np;
    return -1;
}
__device__ __forceinline__ void p0_adaln_item(Frame& F, const Args& args, int it) {
    LAS float* cact = (LAS float*)F.lds;
    LAS float* red = cact + 8192;
    for (int i = F.tid; i < 8192; i += NT) cact[i] = siluf_(args.in[1][i]);
    __syncthreads();
    const int j = it * 64 + F.lane;
    float a[8];
#pragma unroll
    for (int b = 0; b < 8; ++b) a[b] = 0.f;
    const int kb = F.wave * 128;
#pragma unroll 4
    for (int k = kb; k < kb + 128; ++k) { const float w = args.in[2][(size_t)k * 6144 + j];
#pragma unroll
        for (int b = 0; b < 8; ++b) a[b] += cact[b * 1024 + k] * w; }
#pragma unroll
    for (int b = 0; b < 8; ++b) red[(F.wave * 8 + b) * 64 + F.lane] = a[b];
    __syncthreads();
    { const int b = F.tid >> 6, l = F.tid & 63; float s = 0.f;
#pragma unroll
      for (int w = 0; w < 8; ++w) s += red[(w * 8 + b) * 64 + l];
      float* mod = (float*)(F.ws + WS_MOD); mod[b * 6144 + it * 64 + l] = s + args.in[3][it * 64 + l]; }
    __syncthreads();
}
__device__ __forceinline__ void p0_prologue(Frame& F, const Args& args) {
    for (int it = blockIdx.x; it < 96; it += F.G) p0_adaln_item(F, args, it);
    LAS float* scr = (LAS float*)(F.lds + F.wave * 16384);
    const int gw = F.vcu * NWAVES + F.wave, NGW = F.G * NWAVES;
    constexpr int I_IN = (NPAD / 32) * 16, I_OUT = 32 * 16, I_GU = NEXP * 32 * 16, I_D = NEXP * 32 * 8;
    constexpr int NITEMS = I_IN + I_OUT + I_GU + I_D;
    bf16_t* WIN = (bf16_t*)(F.ws + WS_WIN); bf16_t* WOUT = (bf16_t*)(F.ws + WS_WOUT); bf16_t* WGU = (bf16_t*)(F.ws + WS_WGU); bf16_t* WD = (bf16_t*)(F.ws + WS_WD);
    for (int it = gw; it < NITEMS; it += NGW) {
        int r = it;
        if (r < I_IN) { const int nb = r >> 4, kb = r & 15; const int n0 = nb * 32;
            transpose_item(args.in[4], INW, D, WIN + (size_t)n0 * D, kb * 64, scr, F.lane, [n0](int n) { return win_orig_col(n0 + n); }); continue; }
        r -= I_IN;
        if (r < I_OUT) { const int nb = r >> 4, kb = r & 15; const int n0 = nb * 32;
            transpose_item(args.in[13], D, D, WOUT + (size_t)n0 * D, kb * 64, scr, F.lane, [n0](int n) { return n0 + n; }); continue; }
        r -= I_OUT;
        if (r < I_GU) { const int e = r >> 9, rr = r & 511, nb = rr >> 4, kb = rr & 15; const int row0 = nb * 32;
            const int pn = row0 >> 8, half = (row0 >> 7) & 1, j0 = row0 & 127; const int c0 = pn * 128 + j0;
            const float* src = (half ? args.in[21] : args.in[20]) + (size_t)e * D * DEXP;
            transpose_item(src, DEXP, D, WGU + ((size_t)e * 1024 + row0) * D, kb * 64, scr, F.lane, [c0](int n) { return c0 + n; }); continue; }
        r -= I_GU;
        { const int e = r >> 8, rr = r & 255, nb = rr >> 3, kb = rr & 7; const int n0 = nb * 32;
          const float* src = args.in[22] + (size_t)e * DEXP * D;
          transpose_item(src, D, DEXP, WD + ((size_t)e * 1024 + n0) * DEXP, kb * 64, scr, F.lane, [n0](int n) { return n0 + n; }); }
    }
    float* WRT = (float*)(F.ws + WS_WRT);
    for (int i = blockIdx.x * NT + F.tid; i < 36 * 1024; i += F.G * NT) { const int e = i >> 10, k = i & 1023; WRT[i] = e < 4 ? args.in[16][k * 4 + e] : args.in[18][k * 32 + (e - 4)]; }
}
__device__ __forceinline__ void p1_modulate(Frame& F, const Args& args) {
    const float* mod = (const float*)(F.ws + WS_MOD); bf16_t* U = (bf16_t*)(F.dob + DO_U);
    const int gw = F.vcu * NWAVES + F.wave, NGW = F.G * NWAVES;
    for (int t = gw; t < M; t += NGW) {
        const int b = t >> 11; const float* sh = mod + b * 6144; const float* sc = sh + 1024;
        const f32x4* xr = (const f32x4*)(args.in[0] + (size_t)t * D) + F.lane; u32x2* o = (u32x2*)(U + (size_t)t * D) + F.lane;
#pragma unroll
        for (int j = 0; j < 4; ++j) { const f32x4 v = xr[64 * j]; const f32x4 s = *((const f32x4*)sc + F.lane + 64 * j), h = *((const f32x4*)sh + F.lane + 64 * j);
            const f32x4 r = v * (s + 1.0f) + h; u32x2 w; w.x = pk2(r[0], r[1]); w.y = pk2(r[2], r[3]); o[64 * j] = w; }
    }
}

__device__ __forceinline__ int vt_s_of_p(int p) { return 32 * (p >> 5) + 16 * ((p >> 2) & 1) + 4 * ((p >> 3) & 3) + (p & 3); }
__device__ __forceinline__ void p3_mlstm_item(Frame& F, const Args& args, int item) {
    const int ks = item & 3, bh = item >> 2, b = bh >> 2, h = bh & 3, tid = F.tid, lane = F.lane;
    LAS float* ktw = (LAS float*)F.lds;
    LAS float* qraw = ktw + 64 * 32;
    LAS float* kraw = qraw + 67 * 33;
    LAS float* vs = kraw + 67 * 33 + 2;
    LAS float* wsL = vs + 64 * 128;
    LAS float* scl = wsL + 64;
    bf16_t* proj = (bf16_t*)(F.ws + WS_PROJ); const float* gates = (const float*)(F.ws + WS_GATES);
    bf16_t* VT = (bf16_t*)(F.dob + DO_VTM); bf16_t* CT = (bf16_t*)(F.ws + WS_SM);
    float* GB = (float*)(F.ws + WS_GB); float* GA = (float*)(F.ws + WS_GA); float* GPM = (float*)(F.ws + WS_GPM); float* MST = (float*)(F.ws + WS_MST); float* NST = (float*)(F.ws + WS_NST);
    const int qcol = PC_MQ + h * 128 + ks * 32, kcol = PC_MK + h * 128 + ks * 32, vcol = PC_MV + h * 128;
    const int cs = tid >> 3, c4 = tid & 7;
    float wq[4][4], bq[4], wk[4][4], bk[4];
#pragma unroll
    for (int e = 0; e < 4; ++e) { const int ch = h * 128 + ks * 32 + c4 * 4 + e; bq[e] = args.in[6][ch]; bk[e] = args.in[6][512 + ch];
#pragma unroll
        for (int j = 0; j < 4; ++j) { wq[j][e] = args.in[5][j * 1024 + ch]; wk[j][e] = args.in[5][j * 1024 + 512 + ch]; } }
    const float big = args.in[7][h], bfg = args.in[8][h];
    const int cj = tid & 127, iq = tid >> 7;
    float C[8]; float nacc = 0.f, mrun = 0.f;
#pragma unroll
    for (int e = 0; e < 8; ++e) C[e] = 0.f;
    if (tid < 48) { const int which = tid / 24, rr = (tid % 24) >> 3, cc = (tid & 7) * 4; LAS float* d = (which ? kraw : qraw) + rr * 33 + cc; d[0] = 0.f; d[1] = 0.f; d[2] = 0.f; d[3] = 0.f; }
    u32x2 pq, pk; u32x4 pv[2]; float pgi = 0.f, pgf = 0.f;
#define P3M_PREFETCH(c_) do { const int t0_ = b * SEQ + (c_) * 64; \
        pq = *(const u32x2*)(proj + (size_t)(t0_ + (tid >> 3)) * NPROJ + qcol + (tid & 7) * 4); \
        pk = *(const u32x2*)(proj + (size_t)(t0_ + (tid >> 3)) * NPROJ + kcol + (tid & 7) * 4); \
        _Pragma("unroll") for (int q_ = 0; q_ < 2; ++q_) { const int p_ = tid + 512 * q_; pv[q_] = *(const u32x4*)(proj + (size_t)(t0_ + (p_ >> 4)) * NPROJ + vcol + (p_ & 15) * 8); } \
        if (tid < 64) { pgi = gates[(size_t)(t0_ + tid) * 32 + h]; pgf = gates[(size_t)(t0_ + tid) * 32 + 4 + h]; } } while (0)
    P3M_PREFETCH(0);
    for (int c = 0; c < NCH; ++c) {
        const int t0 = b * SEQ + c * 64;
        { const int r = tid >> 3, cc = (tid & 7) * 4; LAS float* d = qraw + (r + 3) * 33 + cc; d[0] = bflo(pq.x); d[1] = bfhi(pq.x); d[2] = bflo(pq.y); d[3] = bfhi(pq.y);
          LAS float* d2 = kraw + (r + 3) * 33 + cc; d2[0] = bflo(pk.x); d2[1] = bfhi(pk.x); d2[2] = bflo(pk.y); d2[3] = bfhi(pk.y); }
#pragma unroll
        for (int q = 0; q < 2; ++q) { const int p = tid + 512 * q; LAS float* d = vs + (p >> 4) * 128 + (p & 15) * 8;
            d[0] = bflo(pv[q].x); d[1] = bfhi(pv[q].x); d[2] = bflo(pv[q].y); d[3] = bfhi(pv[q].y); d[4] = bflo(pv[q].z); d[5] = bfhi(pv[q].z); d[6] = bflo(pv[q].w); d[7] = bfhi(pv[q].w); }
        if (tid < 64) {
            const float ig = pgi + big, lf = logsigf_(pgf + bfg);
            const float bc = wave_scan_add(lf, lane), bL = __shfl(bc, 63);
            const float a = ig - bc, wl = bL - bc + ig;
            const float wmax = wave_max(wl), mnew = fmaxf(bL + mrun, wmax);
            wsL[lane] = __expf(wl - mnew);
            if (lane == 0) scl[0] = __expf(bL + mrun - mnew);
            if (ks == 0) { const float pm = wave_scan_max(a, lane); const int gi = bh * SEQ + c * 64 + lane; GB[gi] = bc; GA[gi] = a; GPM[gi] = pm; if (lane == 0) MST[bh * 32 + c] = mrun; }
            mrun = mnew;
        }
        __syncthreads();
        if (c + 1 < NCH) P3M_PREFETCH(c + 1);
        { float qt[4], kt[4];
#pragma unroll
          for (int e = 0; e < 4; ++e) { float aq = bq[e], ak = bk[e];
#pragma unroll
              for (int j = 0; j < 4; ++j) { aq += wq[j][e] * qraw[(cs + j) * 33 + c4 * 4 + e]; ak += wk[j][e] * kraw[(cs + j) * 33 + c4 * 4 + e]; }
              qt[e] = siluf_(aq); kt[e] = siluf_(ak) * 0.08838834764831845f; }
          const float w = wsL[cs];
          *(LAS f32x4*)(ktw + cs * 32 + c4 * 4) = (f32x4){kt[0] * w, kt[1] * w, kt[2] * w, kt[3] * w};
          u32x2 oq, ok; oq.x = pk2(qt[0], qt[1]); oq.y = pk2(qt[2], qt[3]); ok.x = pk2(kt[0], kt[1]); ok.y = pk2(kt[2], kt[3]);
          *(u32x2*)(proj + (size_t)(t0 + cs) * NPROJ + qcol + c4 * 4) = oq; *(u32x2*)(proj + (size_t)(t0 + cs) * NPROJ + kcol + c4 * 4) = ok; }
        { const int pc = tid >> 5, jl = tid & 31, j = 32 * ks + jl; const int s0 = vt_s_of_p(4 * pc);
          u32x2 o; o.x = pk2(vs[s0 * 128 + j], vs[(s0 + 1) * 128 + j]); o.y = pk2(vs[(s0 + 2) * 128 + j], vs[(s0 + 3) * 128 + j]);
          *(u32x2*)(VT + ((size_t)(bh * 32 + c) * 128 + j) * 64 + 4 * pc) = o; }
        { u32x4 o; o.x = pk2(C[0], C[1]); o.y = pk2(C[2], C[3]); o.z = pk2(C[4], C[5]); o.w = pk2(C[6], C[7]);
          *(u32x4*)(CT + ((size_t)(bh * 32 + c) * 128 + cj) * 128 + ks * 32 + 8 * iq) = o;
          if (tid < 32) NST[(size_t)(bh * 32 + c) * 128 + ks * 32 + tid] = nacc; }
        __syncthreads();
        if (tid < 48) { const int which = tid / 24, rr = (tid % 24) >> 3, cc = (tid & 7) * 4; LAS float* base = which ? kraw : qraw;
            const float h0 = base[(64 + rr) * 33 + cc], h1 = base[(64 + rr) * 33 + cc + 1], h2 = base[(64 + rr) * 33 + cc + 2], h3 = base[(64 + rr) * 33 + cc + 3];
            base[rr * 33 + cc] = h0; base[rr * 33 + cc + 1] = h1; base[rr * 33 + cc + 2] = h2; base[rr * 33 + cc + 3] = h3; }
        { const float dec = scl[0];
#pragma unroll
          for (int e = 0; e < 8; ++e) C[e] *= dec;
#pragma unroll 4
          for (int s = 0; s < 64; ++s) { const float v = vs[s * 128 + cj]; const f32x4 ka = *(const LAS f32x4*)(ktw + s * 32 + 8 * iq), kb = *(const LAS f32x4*)(ktw + s * 32 + 8 * iq + 4);
              C[0] += ka[0] * v; C[1] += ka[1] * v; C[2] += ka[2] * v; C[3] += ka[3] * v; C[4] += kb[0] * v; C[5] += kb[1] * v; C[6] += kb[2] * v; C[7] += kb[3] * v; }
          if (tid < 32) { float a = 0.f;
#pragma unroll 8
              for (int s = 0; s < 64; ++s) a += ktw[s * 32 + tid];
              nacc = dec * nacc + a; } }
        __syncthreads();
    }
#undef P3M_PREFETCH
}
__device__ __forceinline__ void p3_gla_item(Frame& F, const Args& args, int item) {
    const int ks = item & 3, bh = item >> 2, b = bh >> 2, h = bh & 3, tid = F.tid, lane = F.lane;
    LAS float* gaL = (LAS float*)F.lds;
    LAS float* kL = gaL + 64 * 17;
    LAS float* qL = kL + 64 * 17;
    LAS float* laL = qL + 64 * 17;
    LAS float* vs = laL + 64 * 17;
    LAS float* ecl = vs + 64 * 128;
    bf16_t* proj = (bf16_t*)(F.ws + WS_PROJ); const float* gates = (const float*)(F.ws + WS_GATES);
    bf16_t* VT = (bf16_t*)(F.dob + DO_VTG); bf16_t* ST = (bf16_t*)(F.ws + WS_SG);
    const int qcol = PC_GQ + h * 64 + ks * 16, kcol = PC_GK + h * 64 + ks * 16, vcol = PC_GV + h * 128;
    const int ls = tid >> 3, lc = (tid & 7) * 2;
    float wa[2][16], ba[2];
#pragma unroll
    for (int e = 0; e < 2; ++e) { const int ch = h * 64 + ks * 16 + lc + e; ba[e] = args.in[11][ch];
#pragma unroll
        for (int r = 0; r < 16; ++r) wa[e][r] = args.in[10][r * 256 + ch]; }
    const int sj = tid & 127, cq = tid >> 7;
    float S[4] = {0.f, 0.f, 0.f, 0.f};
    f32x2 pga; u32x2 pk; u32x4 pv[2];
#define P3G_PREFETCH(c_) do { const int t0_ = b * SEQ + (c_) * 64; \
        pga = *(const f32x2*)(gates + (size_t)(t0_ + (tid >> 3)) * 32 + 8 + (tid & 7) * 2); \
        pk = *(const u32x2*)(proj + (size_t)(t0_ + ((tid & 255) >> 2)) * NPROJ + (tid < 256 ? kcol : qcol) + (tid & 3) * 4); \
        _Pragma("unroll") for (int q_ = 0; q_ < 2; ++q_) { const int p_ = tid + 512 * q_; pv[q_] = *(const u32x4*)(proj + (size_t)(t0_ + (p_ >> 4)) * NPROJ + vcol + (p_ & 15) * 8); } } while (0)
    P3G_PREFETCH(0);
    for (int c = 0; c < NCH; ++c) {
        const int t0 = b * SEQ + c * 64;
        gaL[(tid >> 3) * 17 + (tid & 7) * 2] = pga[0]; gaL[(tid >> 3) * 17 + (tid & 7) * 2 + 1] = pga[1];
        { LAS float* d = (tid < 256 ? kL : qL) + ((tid & 255) >> 2) * 17 + (tid & 3) * 4; d[0] = bflo(pk.x); d[1] = bfhi(pk.x); d[2] = bflo(pk.y); d[3] = bfhi(pk.y); }
#pragma unroll
        for (int q = 0; q < 2; ++q) { const int p = tid + 512 * q; LAS float* d = vs + (p >> 4) * 128 + (p & 15) * 8;
            d[0] = bflo(pv[q].x); d[1] = bfhi(pv[q].x); d[2] = bflo(pv[q].y); d[3] = bfhi(pv[q].y); d[4] = bflo(pv[q].z); d[5] = bfhi(pv[q].z); d[6] = bflo(pv[q].w); d[7] = bfhi(pv[q].w); }
        __syncthreads();
        if (c + 1 < NCH) P3G_PREFETCH(c + 1);
#pragma unroll
        for (int e = 0; e < 2; ++e) { float acc = ba[e];
#pragma unroll
            for (int r = 0; r < 16; ++r) acc += gaL[ls * 17 + r] * wa[e][r];
            laL[ls * 17 + lc + e] = logsigf_(acc) * 0.0625f; }
        __syncthreads();
#pragma unroll
        for (int e = 0; e < 2; ++e) { const int ch = F.wave * 2 + e; const float x = laL[lane * 17 + ch]; const float cum = wave_scan_add(x, lane);
            const float ep = __expf(cum), em = __expf(-cum);
            kL[lane * 17 + ch] *= em; qL[lane * 17 + ch] *= 0.125f * ep; if (lane == 63) ecl[ch] = ep; }
        { const int pc = tid >> 5, jl = tid & 31, j = 32 * ks + jl; const int s0 = vt_s_of_p(4 * pc);
          u32x2 o; o.x = pk2(vs[s0 * 128 + j], vs[(s0 + 1) * 128 + j]); o.y = pk2(vs[(s0 + 2) * 128 + j], vs[(s0 + 3) * 128 + j]);
          *(u32x2*)(VT + ((size_t)(bh * 32 + c) * 128 + j) * 64 + 4 * pc) = o; }
        { u32x2 o; o.x = pk2(S[0], S[1]); o.y = pk2(S[2], S[3]); *(u32x2*)(ST + ((size_t)(bh * 32 + c) * 128 + sj) * 64 + ks * 16 + 4 * cq) = o; }
        __syncthreads();
        { const LAS float* src = (tid < 256 ? kL : qL) + ((tid & 255) >> 2) * 17 + (tid & 3) * 4; u32x2 o; o.x = pk2(src[0], src[1]); o.y = pk2(src[2], src[3]);
          *(u32x2*)(proj + (size_t)(t0 + ((tid & 255) >> 2)) * NPROJ + (tid < 256 ? kcol : qcol) + (tid & 3) * 4) = o; }
        { float a0 = 0.f, a1 = 0.f, a2 = 0.f, a3 = 0.f;
#pragma unroll 4
          for (int s = 0; s < 64; ++s) { const float v = vs[s * 128 + sj]; const LAS float* kp = kL + s * 17 + 4 * cq; a0 += kp[0] * v; a1 += kp[1] * v; a2 += kp[2] * v; a3 += kp[3] * v; }
          S[0] = ecl[4 * cq] * (S[0] + a0); S[1] = ecl[4 * cq + 1] * (S[1] + a1); S[2] = ecl[4 * cq + 2] * (S[2] + a2); S[3] = ecl[4 * cq + 3] * (S[3] + a3); }
        __syncthreads();
    }
#undef P3G_PREFETCH
}
__device__ __forceinline__ void p3_scan(Frame& F, const Args& args) {
    for (int it = F.vcu; it < 256; it += F.G) { if (it < 128) p3_mlstm_item(F, args, it); else p3_gla_item(F, args, it - 128); }
}

template <bool ML>
__device__ __forceinline__ void p4_task(Frame& F, const Args& args, int item, int rt) {
    constexpr int DK = ML ? 128 : 64, KS = DK / 32;
    const int c = item & 31, bh = item >> 5, b = bh >> 2, h = bh & 3, lane = F.lane, fr = lane & 15, g = lane >> 4;
    const int t0 = b * SEQ + c * 64, trow = t0 + 16 * rt + fr, tl = 16 * rt + fr;
    const bf16_t* proj = (const bf16_t*)(F.ws + WS_PROJ);
    const int qcol = ML ? PC_MQ + h * 128 : PC_GQ + h * 64, kcol = ML ? PC_MK + h * 128 : PC_GK + h * 64;
    const bf16_t* CT = (const bf16_t*)(F.ws + (ML ? WS_SM : WS_SG)) + (size_t)(bh * 32 + c) * 128 * DK;
    const bf16_t* VT = (const bf16_t*)(F.dob + (ML ? DO_VTM : DO_VTG)) + (size_t)(bh * 32 + c) * 128 * 64;
    bf16_t* HC = (bf16_t*)(F.dob + DO_HCAT);
    bf16x8 qf[KS];
#pragma unroll
    for (int kk = 0; kk < KS; ++kk) qf[kk] = *(const bf16x8*)(proj + (size_t)trow * NPROJ + qcol + 32 * kk + 8 * g);
    f32x4 st[4];
#pragma unroll
    for (int a = 0; a < 4; ++a) { st[a] = (f32x4){0.f, 0.f, 0.f, 0.f};
        if (a <= rt) {
#pragma unroll
            for (int kk = 0; kk < KS; ++kk) { const bf16x8 kf = *(const bf16x8*)(proj + (size_t)(t0 + 16 * a + fr) * NPROJ + kcol + 32 * kk + 8 * g);
                st[a] = __builtin_amdgcn_mfma_f32_16x16x32_bf16(kf, qf[kk], st[a], 0, 0, 0); } } }
    float inter = 1.f, inv = 1.f;
    if (ML) {
        const float* GA = (const float*)(F.ws + WS_GA) + bh * SEQ + c * 64; const float* GB = (const float*)(F.ws + WS_GB) + bh * SEQ + c * 64; const float* GPM = (const float*)(F.ws + WS_GPM) + bh * SEQ + c * 64;
        const float mc = ((const float*)(F.ws + WS_MST))[bh * 32 + c];
        const float Mt = fmaxf(GPM[tl], mc), bt = GB[tl];
        float den = 0.f;
#pragma unroll
        for (int a = 0; a < 4; ++a) if (a <= rt) { const f32x4 av = *(const f32x4*)(GA + 16 * a + 4 * g);
#pragma unroll
            for (int r = 0; r < 4; ++r) { const int s = 16 * a + 4 * g + r; const float p = (s <= tl) ? st[a][r] * __expf(av[r] - Mt) : 0.f; st[a][r] = p; den += p; } }
        den += __shfl_xor(den, 16); den += __shfl_xor(den, 32);
        const float* NS = (const float*)(F.ws + WS_NST) + (size_t)(bh * 32 + c) * 128;
        float qn = 0.f;
#pragma unroll
        for (int kk = 0; kk < KS; ++kk) { const f32x4 n0 = *(const f32x4*)(NS + 32 * kk + 8 * g), n1 = *(const f32x4*)(NS + 32 * kk + 8 * g + 4);
            const u32x4 w = __builtin_bit_cast(u32x4, qf[kk]);
            qn += bflo(w.x) * n0[0] + bfhi(w.x) * n0[1] + bflo(w.y) * n0[2] + bfhi(w.y) * n0[3] + bflo(w.z) * n1[0] + bfhi(w.z) * n1[1] + bflo(w.w) * n1[2] + bfhi(w.w) * n1[3]; }
        qn += __shfl_xor(qn, 16); qn += __shfl_xor(qn, 32);
        inter = __expf(mc - Mt);
        den += inter * qn;
        inv = 1.0f / fmaxf(fabsf(den), __expf(-(bt + Mt)));
    } else {
#pragma unroll
        for (int a = 0; a < 4; ++a)
#pragma unroll
            for (int r = 0; r < 4; ++r) { const int s = 16 * a + 4 * g + r; if (s > tl) st[a][r] = 0.f; }
    }
    bf16x8 pf[2];
#pragma unroll
    for (int k2 = 0; k2 < 2; ++k2) { u32x4 w; w.x = pg8::cvt_pk_bf16(st[2 * k2][0], st[2 * k2][1]); w.y = pg8::cvt_pk_bf16(st[2 * k2][2], st[2 * k2][3]);
        w.z = pg8::cvt_pk_bf16(st[2 * k2 + 1][0], st[2 * k2 + 1][1]); w.w = pg8::cvt_pk_bf16(st[2 * k2 + 1][2], st[2 * k2 + 1][3]); pf[k2] = __builtin_bit_cast(bf16x8, w); }
    f32x4 o[8];
#pragma unroll
    for (int n = 0; n < 8; ++n) { f32x4 acc = (f32x4){0.f, 0.f, 0.f, 0.f};
#pragma unroll
        for (int kk = 0; kk < KS; ++kk) { const bf16x8 cf = *(const bf16x8*)(CT + (size_t)(16 * n + fr) * DK + 32 * kk + 8 * g); acc = __builtin_amdgcn_mfma_f32_16x16x32_bf16(cf, qf[kk], acc, 0, 0, 0); }
        if (ML) acc = acc * inter;
#pragma unroll
        for (int k2 = 0; k2 < 2; ++k2) if (2 * k2 <= rt) { const bf16x8 vf = *(const bf16x8*)(VT + (size_t)(16 * n + fr) * 64 + 32 * k2 + 8 * g); acc = __builtin_amdgcn_mfma_f32_16x16x32_bf16(vf, pf[k2], acc, 0, 0, 0); }
        o[n] = acc; }
    float ss = 0.f;
#pragma unroll
    for (int n = 0; n < 8; ++n) { const int col = h * 128 + 16 * n + 4 * g;
        if (ML) { const u32x2 w = *(const u32x2*)(proj + (size_t)trow * NPROJ + PC_MO + col);
            o[n][0] *= inv * sigmoidf_(bflo(w.x)); o[n][1] *= inv * sigmoidf_(bfhi(w.x)); o[n][2] *= inv * sigmoidf_(bflo(w.y)); o[n][3] *= inv * sigmoidf_(bfhi(w.y)); }
        ss += (o[n][0] * o[n][0] + o[n][1] * o[n][1]) + (o[n][2] * o[n][2] + o[n][3] * o[n][3]); }
    ss += __shfl_xor(ss, 16); ss += __shfl_xor(ss, 32);
    const float rstd = 1.0f / sqrtf(ss * (1.0f / 128.0f) + LN_EPS);
#pragma unroll
    for (int n = 0; n < 8; ++n) { const int col = h * 128 + 16 * n + 4 * g; const f32x4 gm = *(const f32x4*)((ML ? args.in[9] : args.in[12]) + col);
        f32x4 r = o[n] * rstd * gm;
        if (!ML) { const u32x2 w = *(const u32x2*)(proj + (size_t)trow * NPROJ + PC_GG + col); r[0] *= siluf_(bflo(w.x)); r[1] *= siluf_(bfhi(w.x)); r[2] *= siluf_(bflo(w.y)); r[3] *= siluf_(bfhi(w.y)); }
        u32x2 ov; ov.x = pk2(r[0], r[1]); ov.y = pk2(r[2], r[3]);
        *(u32x2*)(HC + (size_t)trow * D + (ML ? 0 : 512) + col) = ov; }
}
__device__ __forceinline__ void p4_chunks(Frame& F, const Args& args) {
    const int gw = F.vcu * NWAVES + F.wave, NGW = F.G * NWAVES;
    for (int w = gw; w < 8192; w += NGW) { const int item = w >> 2, rt = w & 3; if (item < 1024) p4_task<true>(F, args, item, rt); else p4_task<false>(F, args, item - 1024, rt); }
}

__device__ __forceinline__ void p5b_ln_route(Frame& F, const Args& args) {
    LAS int* lcnt = (LAS int*)F.lds;
    LAS int* lbase = lcnt + 32;
    LAS int* rec_e = lbase + 32;
    LAS int* rec_rank = rec_e + 128;
    LAS int* rec_idx = rec_rank + 128;
    LAS float* rec_w = (LAS float*)(rec_idx + 128);
    const float* mod = (const float*)(F.ws + WS_MOD); const float* WRT = (const float*)(F.ws + WS_WRT);
    float* Y = (float*)(F.ws + WS_Y); bf16_t* U2 = (bf16_t*)(F.ws + WS_U2);
    int* list = (int*)(F.ws + WS_LIST); float* rtw = (float*)(F.ws + WS_RTW);
    const int lane = F.lane, tid = F.tid;
    for (int rb = F.vcu; rb < M / 64; rb += F.G) {
        if (tid < 32) lcnt[tid] = 0;
        __syncthreads();
        for (int q = 0; q < 8; ++q) {
            const int lr = F.wave * 8 + q, t = rb * 64 + lr, b = t >> 11;
            const float* mb = mod + b * 6144;
            f32x4 z[4]; float s = 0.f;
#pragma unroll
            for (int j = 0; j < 4; ++j) { const int k = 4 * lane + 256 * j; const f32x4 xv = *(const f32x4*)(args.in[0] + (size_t)t * D + k), yv = *(const f32x4*)(Y + (size_t)t * D + k), g1 = *(const f32x4*)(mb + 2048 + k);
                z[j] = xv * DN_ALPHA + (g1 + 1.0f) * yv; s += (z[j][0] + z[j][1]) + (z[j][2] + z[j][3]); }
            const float mean = wave_sum(s) * (1.0f / D); float s2 = 0.f;
#pragma unroll
            for (int j = 0; j < 4; ++j) { z[j] = z[j] - mean; s2 += (z[j][0] * z[j][0] + z[j][1] * z[j][1]) + (z[j][2] * z[j][2] + z[j][3] * z[j][3]); }
            const float rstd = 1.0f / sqrtf(wave_sum(s2) * (1.0f / D) + LN_EPS);
            f32x4 u2[4];
#pragma unroll
            for (int j = 0; j < 4; ++j) { const int k = 4 * lane + 256 * j; const f32x4 lg = *(const f32x4*)(args.in[14] + k), lb = *(const f32x4*)(args.in[15] + k);
                const f32x4 x1 = z[j] * rstd * lg + lb; *(f32x4*)(Y + (size_t)t * D + k) = x1;
                const f32x4 sc2 = *(const f32x4*)(mb + 4096 + k), sh2 = *(const f32x4*)(mb + 3072 + k);
                u2[j] = x1 * (sc2 + 1.0f) + sh2; u32x2 w; w.x = pk2(u2[j][0], u2[j][1]); w.y = pk2(u2[j][2], u2[j][3]); *(u32x2*)(U2 + (size_t)t * D + k) = w; }
            float mylogit = 0.f;
#pragma unroll 2
            for (int e = 0; e < 36; ++e) { float p = 0.f;
#pragma unroll
                for (int j = 0; j < 4; ++j) { const f32x4 w = *(const f32x4*)(WRT + e * 1024 + 4 * lane + 256 * j); p += (u2[j][0] * w[0] + u2[j][1] * w[1]) + (u2[j][2] * w[2] + u2[j][3] * w[3]); }
                p = wave_sum(p);
                if (lane == e) mylogit = p; }
            if (lane < 4) mylogit += args.in[17][lane]; else if (lane < 36) mylogit += args.in[19][lane - 4];
            float lg4[4];
#pragma unroll
            for (int i = 0; i < 4; ++i) lg4[i] = __shfl(mylogit, i);
            int gs = 0; float gm = lg4[0];
#pragma unroll
            for (int i = 1; i < 4; ++i) if (lg4[i] > gm) { gm = lg4[i]; gs = i; }
            float gsum = 0.f;
#pragma unroll
            for (int i = 0; i < 4; ++i) gsum += __expf(lg4[i] - gm);
            const float pg = 1.0f / gsum;
            float ein[8];
#pragma unroll
            for (int i = 0; i < 8; ++i) ein[i] = __shfl(mylogit, 4 + gs * 8 + i);
            int i1 = 0; float v1 = ein[0];
#pragma unroll
            for (int i = 1; i < 8; ++i) if (ein[i] > v1) { v1 = ein[i]; i1 = i; }
            int i2 = -1; float v2 = -3.0e38f;
#pragma unroll
            for (int i = 0; i < 8; ++i) if (i != i1 && ein[i] > v2) { v2 = ein[i]; i2 = i; }
            const float ex = __expf(v2 - v1); const float p1 = 1.0f / (1.0f + ex), p2 = ex * p1;
            if (lane == 0) {
                const int e1 = gs * 8 + i1, e2 = gs * 8 + i2;
                const int r1 = atomicAdd((int*)&lcnt[e1], 1), r2 = atomicAdd((int*)&lcnt[e2], 1);
                rec_e[lr * 2] = e1; rec_rank[lr * 2] = r1; rec_idx[lr * 2] = t * 2; rec_w[lr * 2] = pg * p1;
                rec_e[lr * 2 + 1] = e2; rec_rank[lr * 2 + 1] = r2; rec_idx[lr * 2 + 1] = t * 2 + 1; rec_w[lr * 2 + 1] = pg * p2;
            }
        }
        __syncthreads();
        if (tid < 32) { const int n = lcnt[tid]; lbase[tid] = n ? (int)__hip_atomic_fetch_add(F.ctl + CW_ECNT + 64 * tid, (unsigned)n, RLX_AGENT) : 0; }
        __syncthreads();
        if (tid < 128) { const int e = rec_e[tid], pos = lbase[e] + rec_rank[tid], idx = rec_idx[tid]; list[(size_t)e * LISTCAP + pos] = idx; rtw[idx] = rec_w[tid]; }
        __syncthreads();
    }
}
__device__ __forceinline__ void moe_tables(Frame& F) {
    LAS int* tab = (LAS int*)(F.lds + MOE_OFF);
    if (F.tid < 32) tab[66 + F.tid] = (int)__hip_atomic_load(F.ctl + CW_ECNT + 64 * F.tid, RLX_AGENT);
    __syncthreads();
    if (F.tid == 0) { int ts = 0, hr = 0; for (int e = 0; e < 32; ++e) { tab[e] = ts; tab[33 + e] = hr; const int nt = (tab[66 + e] + 255) >> 8; ts += nt; hr += nt * 256; } tab[32] = ts; tab[65] = hr; }
    __syncthreads();
}
__device__ __forceinline__ void p7_final(Frame& F, const Args& args) {
    const float* mod = (const float*)(F.ws + WS_MOD); const float* X1 = (const float*)(F.ws + WS_Y); const bf16_t* Y2 = (const bf16_t*)(F.dob + DO_Y2);
    const int gw = F.vcu * NWAVES + F.wave, NGW = F.G * NWAVES, lane = F.lane;
    for (int t = gw; t < M; t += NGW) {
        const int b = t >> 11; const float* mb = mod + b * 6144;
        f32x4 z[4]; float s = 0.f;
#pragma unroll
        for (int j = 0; j < 4; ++j) { const int k = 4 * lane + 256 * j; const f32x4 xv = *(const f32x4*)(X1 + (size_t)t * D + k), g2 = *(const f32x4*)(mb + 5120 + k);
            const u32x2 wa = *(const u32x2*)(Y2 + (size_t)(2 * t) * D + k), wb = *(const u32x2*)(Y2 + (size_t)(2 * t + 1) * D + k);
            const f32x4 yv = (f32x4){bflo(wa.x) + bflo(wb.x), bfhi(wa.x) + bfhi(wb.x), bflo(wa.y) + bflo(wb.y), bfhi(wa.y) + bfhi(wb.y)};
            z[j] = xv * DN_ALPHA + (g2 + 1.0f) * yv; s += (z[j][0] + z[j][1]) + (z[j][2] + z[j][3]); }
        const float mean = wave_sum(s) * (1.0f / D); float s2 = 0.f;
#pragma unroll
        for (int j = 0; j < 4; ++j) { z[j] = z[j] - mean; s2 += (z[j][0] * z[j][0] + z[j][1] * z[j][1]) + (z[j][2] * z[j][2] + z[j][3] * z[j][3]); }
        const float rstd = 1.0f / sqrtf(wave_sum(s2) * (1.0f / D) + LN_EPS);
#pragma unroll
        for (int j = 0; j < 4; ++j) { const int k = 4 * lane + 256 * j; const f32x4 lg = *(const f32x4*)(args.in[23] + k), lb = *(const f32x4*)(args.in[24] + k);
            *(f32x4*)(F.out + (size_t)t * D + k) = z[j] * rstd * lg + lb; }
    }
}

__global__ void __launch_bounds__(NT, 2) mega_fwd(Args args) {
    extern __shared__ __attribute__((aligned(16))) unsigned char lds_raw[];
    Frame F;
    F.lds = (LAS unsigned char*)lds_raw;
    F.tid = threadIdx.x; F.lane = F.tid & 63; F.wave = __builtin_amdgcn_readfirstlane(F.tid >> 6);
    F.G = gridDim.x; { const int bx = blockIdx.x; F.vcu = (F.G % 8 == 0) ? (bx % 8) * (F.G / 8) + bx / 8 : bx; }
    F.ws = args.ws; F.ctl = (unsigned*)(args.ws + WS_CTL); F.out = args.out; F.dob = (unsigned char*)args.out;
    for (int u = F.tid; u < (LDS_BYTES - LDSCTL_OFF) / 4; u += NT) ((LAS unsigned*)(F.lds + LDSCTL_OFF))[u] = 0u;
    __syncthreads();
    XcdBarrier bar = xcd_barrier_post(F.ctl + CW_BAR, (volatile LAS unsigned*)(F.lds + MISC_OFF) + 8);
#define GRID_BAR() xcd_barrier(bar)
#ifndef RPT_MASK
#define RPT_MASK 0
#endif
#define NREP(k) ((((RPT_MASK) >> (k)) & 1) + 1)
#define PHASE_ENTER() asm volatile("" : "+s"(F.ws), "+s"(F.dob), "+s"(F.ctl), "+v"(F.tid), "+v"(F.lane), "+s"(F.vcu), "+s"(F.G))
    for (int rep = 0; rep < NREP(0); ++rep) { PHASE_ENTER(); p0_prologue(F, args); GRID_BAR(); }
    for (int rep = 0; rep < NREP(1); ++rep) { PHASE_ENTER(); p1_modulate(F, args); GRID_BAR(); }
    for (int rep = 0; rep < NREP(2); ++rep) {
      PHASE_ENTER();
      { pg8::DenseSched S; S.init(F.dob + DO_U, F.ws + WS_WIN, M, NPAD, D, F.G, (int)blockIdx.x);
        EpiProj E{(bf16_t*)(F.ws + WS_PROJ), (float*)(F.ws + WS_GATES)};
        pg8::gemm_phase<false, true>(F.lds, D, S, E); }
      GRID_BAR(); }
    for (int rep = 0; rep < NREP(3); ++rep) { PHASE_ENTER(); p3_scan(F, args); GRID_BAR(); }
    for (int rep = 0; rep < NREP(4); ++rep) { PHASE_ENTER(); p4_chunks(F, args); GRID_BAR(); }
    for (int rep = 0; rep < NREP(5); ++rep) {
      PHASE_ENTER();
      { pg8::DenseSched S; S.init(F.dob + DO_HCAT, F.ws + WS_WOUT, M, D, D, F.G, (int)blockIdx.x);
        EpiF32 E{(float*)(F.ws + WS_Y)};
        pg8::gemm_phase<false, true>(F.lds, D, S, E); }
      GRID_BAR(); }
    PHASE_ENTER();
    p5b_ln_route(F, args);
    GRID_BAR();
    PHASE_ENTER();
    moe_tables(F);
    for (int rep = 0; rep < NREP(6); ++rep) {
      PHASE_ENTER();
      { pg8::MoeSched S{(const char*)(F.ws + WS_U2), (const char*)(F.ws + WS_WGU), (size_t)1024 * 1024 * 2, D, (const LAS int*)(F.lds + MOE_OFF), (const int*)(F.ws + WS_LIST), F.G, (int)blockIdx.x, true};
        EpiHid E{(bf16_t*)(F.ws + WS_HID)};
        pg8::gemm_phase<true, true>(F.lds, D, S, E); }
      GRID_BAR(); }
    for (int rep = 0; rep < NREP(7); ++rep) {
      PHASE_ENTER();
      { pg8::MoeSched S{(const char*)(F.ws + WS_HID), (const char*)(F.ws + WS_WD), (size_t)1024 * 512 * 2, DEXP, (const LAS int*)(F.lds + MOE_OFF), (const int*)(F.ws + WS_LIST), F.G, (int)blockIdx.x, false};
        EpiY2 E{(bf16_t*)(F.dob + DO_Y2), (const float*)(F.ws + WS_RTW)};
        pg8::gemm_phase<false, true>(F.lds, DEXP, S, E); }
      GRID_BAR(); }
    PHASE_ENTER();
    p7_final(F, args);
}

extern "C" void kernel_launch(void* const* d_in, const int* in_sizes, int n_in, void* d_out, int out_size, void* d_ws, size_t ws_size, hipStream_t stream) {
    static int grid = 0;
    if (grid == 0) {
        if (n_in != 25 || out_size != M * D || ws_size < WS_END) { fprintf(stderr, "kernel_launch: unexpected problem (n_in %d out %d ws %zu)\n", n_in, out_size, ws_size); grid = -1; return; }
        int dev = 0, cus = 0;
        if (hipGetDevice(&dev) != hipSuccess || hipDeviceGetAttribute(&cus, hipDeviceAttributeMultiprocessorCount, dev) != hipSuccess) { grid = -1; return; }
        if (hipFuncSetAttribute((const void*)mega_fwd, hipFuncAttributeMaxDynamicSharedMemorySize, LDS_BYTES) != hipSuccess) { fprintf(stderr, "kernel_launch: hipFuncSetAttribute failed\n"); grid = -1; return; }
        int per_cu = 0;
        (void)hipOccupancyMaxActiveBlocksPerMultiprocessor(&per_cu, (const void*)mega_fwd, NT, LDS_BYTES);
        (void)hipGetLastError();
        if (per_cu < 1) fprintf(stderr, "kernel_launch: occupancy query says %d\n", per_cu);
        grid = cus;
    }
    if (grid < 0) return;
    (void)hipMemsetAsync((char*)d_ws + WS_CTL, 0, CTL_ZERO_BYTES, stream);
    Args a{};
    for (int i = 0; i < 25; ++i) a.in[i] = (const float*)d_in[i];
    a.out = (float*)d_out; a.ws = (unsigned char*)d_ws;
    hipLaunchKernelGGL(mega_fwd, dim3(grid), dim3(NT), LDS_BYTES, stream, a);
}
```

```cpp
#include <hip/hip_runtime.h>
#include <cstdio>
#include <cstdint>

#define GAS __attribute__((address_space(1)))
#define LAS __attribute__((address_space(3)))
typedef unsigned short bf16_t;
typedef short bf16x8 __attribute__((ext_vector_type(8)));
typedef float f32x4 __attribute__((ext_vector_type(4)));
typedef float f32x2 __attribute__((ext_vector_type(2)));
typedef unsigned u32x4 __attribute__((ext_vector_type(4)));
typedef unsigned u32x2 __attribute__((ext_vector_type(2)));

constexpr int D = 1024, BATCH = 8, SEQ = 2048, M = BATCH * SEQ;
constexpr int INW = 3608, NPROJ = 3584, NPAD = 3840;
constexpr int NCH = SEQ / 64;
constexpr int NEXP = 32, DEXP = 512, LISTCAP = 16384;
constexpr float LN_EPS = 1e-5f;
constexpr float DN_ALPHA = 1.189207115002721f;
constexpr int PC_MQ = 0, PC_MK = 512, PC_MV = 1024, PC_MO = 1536, PC_GQ = 2048, PC_GK = 2304, PC_GV = 2560, PC_GG = 3072;

constexpr size_t MiB = 1u << 20;
constexpr size_t WS_CTL = 0, CTL_ZERO_BYTES = 1 * MiB;
constexpr size_t WS_MOD = 1 * MiB;
constexpr size_t WS_WRT = 1 * MiB + 512 * 1024;
constexpr size_t WS_RTW = 2 * MiB;
constexpr size_t WS_GB = 2 * MiB + 256 * 1024;
constexpr size_t WS_GA = 2 * MiB + 512 * 1024;
constexpr size_t WS_MST = 2 * MiB + 768 * 1024;
constexpr size_t WS_GPM = 1 * MiB + 768 * 1024;
constexpr size_t WS_BL = 2 * MiB + 776 * 1024;
constexpr size_t WS_WM = 2 * MiB + 784 * 1024;
constexpr size_t WS_ECL = 2 * MiB + 800 * 1024;
constexpr size_t WS_NST = 3 * MiB + 512 * 1024;
constexpr size_t WS_LIST = 4 * MiB;
constexpr size_t WS_GATES = 6 * MiB;
constexpr size_t WS_WIN = 8 * MiB;
constexpr size_t WS_WOUT = 16 * MiB;
constexpr size_t WS_WGU = 18 * MiB;
constexpr size_t WS_WD = 82 * MiB;
constexpr size_t WS_SM = 114 * MiB;
constexpr size_t WS_SG = 146 * MiB;
constexpr size_t WS_HID = 114 * MiB;
constexpr size_t WS_PROJ = 162 * MiB;
constexpr size_t WS_Y = 162 * MiB;
constexpr size_t WS_U2 = 226 * MiB;
constexpr size_t WS_HALO = 274 * MiB;
constexpr size_t WS_END = 276 * MiB;
constexpr size_t DO_U = 0, DO_VTM = 0, DO_VTG = 16 * MiB, DO_HCAT = 32 * MiB, DO_Y2 = 0;

constexpr int CW_TMO = 0;
constexpr int CW_BAR = 4096;
constexpr int CW_ECNT = 16384;
constexpr int CW_DBG = 32768;

constexpr int RING_BYTES = 131072;
constexpr int WORK_BYTES = 147456;
constexpr int LDSCTL_OFF = WORK_BYTES, MISC_OFF = LDSCTL_OFF + 320;
constexpr int MOE_OFF = LDSCTL_OFF + 1024;
constexpr int LDS_BYTES = WORK_BYTES + 8192;
constexpr int NWAVES = 8, NT = 512;

#define RLX_AGENT __ATOMIC_RELAXED, __HIP_MEMORY_SCOPE_AGENT
#define LDS_WAIT() asm volatile("s_waitcnt lgkmcnt(0)" ::: "memory")
#define VM_WAIT() asm volatile("s_waitcnt vmcnt(0)" ::: "memory")

__device__ __forceinline__ unsigned f2bf(float f) { unsigned u = __builtin_bit_cast(unsigned, f); return (u + 0x7fffu + ((u >> 16) & 1u)) >> 16; }
__device__ __forceinline__ unsigned pk2(float lo, float hi) { return f2bf(lo) | (f2bf(hi) << 16); }
__device__ __forceinline__ float bf2f(unsigned short h) { return __builtin_bit_cast(float, (unsigned)h << 16); }
__device__ __forceinline__ float bflo(unsigned w) { return __builtin_bit_cast(float, w << 16); }
__device__ __forceinline__ float bfhi(unsigned w) { return __builtin_bit_cast(float, w & 0xffff0000u); }
__device__ __forceinline__ float sigmoidf_(float x) { return 1.0f / (1.0f + __expf(-x)); }
__device__ __forceinline__ float siluf_(float x) { return x / (1.0f + __expf(-x)); }
__device__ __forceinline__ float logsigf_(float x) { return fminf(x, 0.0f) - log1pf(__expf(-fabsf(x))); }
template <int CTRL> __device__ __forceinline__ float dppf(float v) { return __builtin_bit_cast(float, __builtin_amdgcn_update_dpp(0, __builtin_bit_cast(int, v), CTRL, 0xF, 0xF, false)); }
__device__ __forceinline__ float rdlane(float v, int l) { return __builtin_bit_cast(float, __builtin_amdgcn_readlane(__builtin_bit_cast(int, v), l)); }
__device__ __forceinline__ float wave_sum(float v) {
    v += dppf<0xB1>(v); v += dppf<0x4E>(v); v += dppf<0x141>(v); v += dppf<0x140>(v);
    return (rdlane(v, 0) + rdlane(v, 16)) + (rdlane(v, 32) + rdlane(v, 48));
}
__device__ __forceinline__ float wave_max(float v) {
    v = fmaxf(v, dppf<0xB1>(v)); v = fmaxf(v, dppf<0x4E>(v)); v = fmaxf(v, dppf<0x141>(v)); v = fmaxf(v, dppf<0x140>(v));
    return fmaxf(fmaxf(rdlane(v, 0), rdlane(v, 16)), fmaxf(rdlane(v, 32), rdlane(v, 48)));
}
__device__ __forceinline__ float wave_scan_add(float v, int lane) {
#pragma unroll
    for (int o = 1; o < 64; o <<= 1) { float t = __shfl_up(v, o); if (lane >= o) v += t; }
    return v;
}
__device__ __forceinline__ float wave_scan_max(float v, int lane) {
#pragma unroll
    for (int o = 1; o < 64; o <<= 1) { float t = __shfl_up(v, o); if (lane >= o) v = fmaxf(v, t); }
    return v;
}

#define XB_TMO      128
#define XB_XCNT(j)  (256  + 64 * (j))
#define XB_XSUB(j)  (1280 + 64 * (j))
#define XB_XGEN(j)  (2304 + 64 * (j))
#define XB_TOP      3328
#define XB_TOPGEN   3392
#define XCD_BAR_WORDS 3456
#define XB_SPIN_CAP (1u << 18)
__device__ __forceinline__ unsigned xb_ld(unsigned* p)              { return __hip_atomic_load(p, __ATOMIC_RELAXED, __HIP_MEMORY_SCOPE_AGENT); }
__device__ __forceinline__ unsigned xb_add(unsigned* p, unsigned v) { return __hip_atomic_fetch_add(p, v, __ATOMIC_RELAXED, __HIP_MEMORY_SCOPE_AGENT); }
__device__ __forceinline__ unsigned xb_xcc_id() { return (unsigned)__builtin_amdgcn_s_getreg((3 << 11) | 20) & 0xFu; }
#define XB_SPIN(cond, bar) do { unsigned _sp = 0; while (cond) { __builtin_amdgcn_s_sleep(1); \
    if ((++_sp & 255u) == 0u) { if (xb_ld(&(bar)[XB_TMO])) break; if (_sp > XB_SPIN_CAP) { atomicAdd(&(bar)[XB_TMO], 1u); break; } } } } while (0)
struct XcdBarrier { unsigned* bar; unsigned x; volatile LAS unsigned* st; };
__device__ __forceinline__ XcdBarrier xcd_barrier_post(unsigned* bar, volatile LAS unsigned* st) {
    XcdBarrier b; b.bar = bar; b.x = xb_xcc_id(); b.st = st;
    if (threadIdx.x == 0) (void)xb_add(&bar[XB_XCNT(b.x)], 1u);
    return b;
}
__device__ __forceinline__ void xcd_barrier_complete(unsigned* bar, unsigned x, unsigned& nloc, unsigned& nx) {
    const unsigned G = gridDim.x * gridDim.y * gridDim.z;
    unsigned sum, cnt, mine, sp = 0u;
    for (;;) {
        sum = 0u; cnt = 0u; mine = 0u;
#pragma unroll
        for (unsigned j = 0; j < 16; ++j) { const unsigned c = xb_ld(&bar[XB_XCNT(j)]); sum += c; cnt += (c > 0u) ? 1u : 0u; mine = (j == x) ? c : mine; }
        if (sum == G) break;
        __builtin_amdgcn_s_sleep(1);
        if ((++sp & 255u) == 0u) { if (xb_ld(&bar[XB_TMO])) break; if (sp > XB_SPIN_CAP) { atomicAdd(&bar[XB_TMO], 1u); break; } }
    }
    nloc = mine > 0u ? mine : 1u; nx = cnt > 0u ? cnt : 1u;
}
__device__ __forceinline__ void xcd_barrier(const XcdBarrier& b) {
    asm volatile("s_waitcnt vmcnt(0)" ::: "memory");
    __syncthreads();
    if (threadIdx.x == 0) {
        unsigned* bar = b.bar;
        __builtin_amdgcn_s_waitcnt(0);
        unsigned nloc = b.st[0], nx = b.st[1];
        if (nloc == 0u) { xcd_barrier_complete(bar, b.x, nloc, nx); b.st[0] = nloc; b.st[1] = nx; }
        const unsigned old = xb_add(&bar[XB_XSUB(b.x)], 1u);
        const unsigned gen = old / nloc;
        if (old + 1u == (gen + 1u) * nloc) {
            __builtin_amdgcn_fence(__ATOMIC_RELEASE, "agent");
            asm volatile("s_waitcnt vmcnt(0)" ::: "memory");
            const unsigned og = xb_add(&bar[XB_TOP], 1u);
            const unsigned tg = og / nx;
            if (og + 1u == (tg + 1u) * nx) xb_add(&bar[XB_TOPGEN], 1u);
            else XB_SPIN(xb_ld(&bar[XB_TOPGEN]) == tg, bar);
            __builtin_amdgcn_fence(__ATOMIC_ACQUIRE, "agent");
            xb_add(&bar[XB_XGEN(b.x)], 1u);
            asm volatile("s_waitcnt vmcnt(0)" ::: "memory");
        } else {
            XB_SPIN(xb_ld(&bar[XB_XGEN(b.x)]) == gen, bar);
            __builtin_amdgcn_fence(__ATOMIC_ACQUIRE, "agent");
            asm volatile("s_waitcnt vmcnt(0)" ::: "memory");
        }
    }
    __syncthreads();
}

namespace pg8 {
constexpr int BM = 256, BK = 64, HALF = 128, HTB = HALF * BK * 2, STAGE_BYTES = 8 * HTB, NXCD = 8, WGM = 8;
__host__ __device__ __forceinline__ int lds_byte(int r, int c) { const int st = (r >> 4) * 2 + (c >> 5), rr = r & 15, cc = c & 31, ob = rr * 64 + cc * 2; return st * 1024 + (ob ^ (((ob >> 9) & 1) << 5)); }
__host__ __device__ __forceinline__ void stage_rc(int b, int& R, int& C) { const int st = b / 1024, sb = b % 1024, swz = sb ^ (((sb >> 9) & 1) << 5); R = (st >> 1) * 16 + swz / 64; C = (st & 1) * 32 + (swz % 64) / 2; }
__host__ __device__ __forceinline__ int perm32(int rho) { const int n = rho >> 4, i = rho & 15; return 8 * (i >> 2) + 4 * n + (i & 3); }
__device__ __forceinline__ unsigned cvt_pk_bf16(float lo, float hi) { unsigned r; asm volatile("v_cvt_pk_bf16_f32 %0, %1, %2" : "=v"(r) : "v"(lo), "v"(hi)); return r; }

struct GUnit { const char* A; const char* B; const int* rows; int nvalid, pm, pn, e, orow0; };

struct DenseSched {
    const char* A; const char* Bt; int K, nM, nN, nwg, G, c;
    __device__ void init(const void* A_, const void* Bt_, int M_, int N_, int K_, int G_, int c_) { A = (const char*)A_; Bt = (const char*)Bt_; K = K_; nM = M_ / BM; nN = N_ / BM; nwg = nM * nN; G = G_; c = c_; }
    __device__ bool next(int i, GUnit& u) const {
        const long L = (long)i * G + c; if (L >= nwg) return false;
        int wgid = (int)L; { const int q = nwg / NXCD, r = nwg % NXCD, xcd = wgid % NXCD, off = wgid / NXCD; wgid = (xcd < r ? xcd * (q + 1) : r * (q + 1) + (xcd - r) * q) + off; }
        const int nig = WGM * nN, gid = wgid / nig, fm = gid * WGM, gsz = (nM - fm) < WGM ? (nM - fm) : WGM;
        u.pm = fm + ((wgid % nig) % gsz); u.pn = (wgid % nig) / gsz;
        u.A = A + (size_t)u.pm * BM * K * 2; u.B = Bt + (size_t)u.pn * BM * K * 2; u.rows = nullptr; u.nvalid = BM; u.e = 0; u.orow0 = u.pm * BM;
        return true;
    }
};
struct MoeSched {
    const char* A; const char* Bt; size_t bstride; int K; const LAS int* tab; const int* list; int G, c; bool gather;
    __device__ bool next(int i, GUnit& u) const {
        const int nrt = __builtin_amdgcn_readfirstlane(tab[32]), nwg = nrt * 4;
        const long L = (long)i * G + c; if (L >= nwg) return false;
        int wgid = (int)L; { const int q = nwg / NXCD, r = nwg % NXCD, xcd = wgid % NXCD, off = wgid / NXCD; wgid = (xcd < r ? xcd * (q + 1) : r * (q + 1) + (xcd - r) * q) + off; }
        const int rt = wgid >> 2; u.pn = wgid & 3;
        int e = 0;
        for (int j = 1; j < 32; ++j) if (tab[j] <= rt) e = j;
        e = __builtin_amdgcn_readfirstlane(e);
        const int ts_e = __builtin_amdgcn_readfirstlane(tab[e]), hr_e = __builtin_amdgcn_readfirstlane(tab[33 + e]), cnt_e = __builtin_amdgcn_readfirstlane(tab[66 + e]);
        const int mt = rt - ts_e;
        u.e = e; u.pm = mt; const int left = cnt_e - BM * mt; u.nvalid = left < BM ? left : BM;
        u.rows = list + (size_t)e * LISTCAP + BM * mt; u.orow0 = hr_e + BM * mt;
        u.A = gather ? A : A + (size_t)u.orow0 * K * 2; u.B = Bt + (size_t)e * bstride + (size_t)u.pn * BM * K * 2;
        return true;
    }
};

template <bool GATHER, bool ALIGN_EPI, class Epi, class Sched>
__device__ __forceinline__ void gemm_phase(LAS unsigned char* lds, const int K, const Sched& S, const Epi& E) {
    int tid_ = threadIdx.x; asm volatile("" : "+v"(tid_));
    const int tid = tid_, wid = __builtin_amdgcn_readfirstlane(tid >> 6), lane = tid & 63, wr = wid >> 2, wc = wid & 3, fr = lane & 15, fq = lane >> 4;
    const int nt = K / BK;
    unsigned voffB[2];
#pragma unroll
    for (int i = 0; i < 2; ++i) { int R, C; stage_rc(tid * 16 + i * 8192, R, C); const int Rb = Epi::PERM ? ((R & ~31) + perm32(R & 31)) : R; voffB[i] = (unsigned)(Rb * K + C) * 2u; }
    const size_t kstep = (size_t)(BK * 2);
    const size_t hstep = (size_t)HALF * K * 2;
    const unsigned ldsw = (unsigned)wid * 1024u;
    const int aoff = lds_byte(wr * 64 + fr, fq * 8), boff = lds_byte(wc * 32 + fr, fq * 8);
#define PG8_SA(b, h) (((b) * 2 + (h)) * HTB)
#define PG8_SB(b, h) ((4 + (b) * 2 + (h)) * HTB)
#define PG8_STAGE(bufoff, gbase, voff) do { _Pragma("unroll") for (int _i = 0; _i < 2; ++_i) \
        __builtin_amdgcn_global_load_lds((const unsigned*)((const char*)(gbase) + (voff)[_i]), (LAS unsigned*)(lds + (bufoff) + ldsw + _i * 8192), 16, 0, 0); } while (0)
#define PG8_LDA(dst, b, h) do { _Pragma("unroll") for (int m = 0; m < 4; ++m) _Pragma("unroll") for (int k = 0; k < 2; ++k) dst[m][k] = *(const LAS bf16x8*)(lds + PG8_SA(b, h) + aoff + m * 2048 + k * 1024); } while (0)
#define PG8_LDB(dst, b, h) do { _Pragma("unroll") for (int n = 0; n < 2; ++n) _Pragma("unroll") for (int k = 0; k < 2; ++k) dst[n][k] = *(const LAS bf16x8*)(lds + PG8_SB(b, h) + boff + n * 2048 + k * 1024); } while (0)
#define PG8_MMA(ai, bj, At, Bt) do { __builtin_amdgcn_s_setprio(1); _Pragma("unroll") for (int m = 0; m < 4; ++m) _Pragma("unroll") for (int n = 0; n < 2; ++n) _Pragma("unroll") for (int k = 0; k < 2; ++k) \
        acc[ai][bj][m][n] = __builtin_amdgcn_mfma_f32_16x16x32_bf16(Bt[n][k], At[m][k], acc[ai][bj][m][n], 0, 0, 0); __builtin_amdgcn_s_setprio(0); } while (0)
#define PG8_WAIT_V(n) asm volatile("s_waitcnt vmcnt(" #n ")" ::: "memory")
#define PG8_WAIT_L(n) asm volatile("s_waitcnt lgkmcnt(" #n ")" ::: "memory")
#define PG8_BAR __builtin_amdgcn_s_barrier()
#define PG8_SCHED __builtin_amdgcn_sched_barrier(0)
#define PG8_MKVA(u, v0, v1) do { _Pragma("unroll") for (int _i = 0; _i < 2; ++_i) { int _R, _C; stage_rc(tid * 16 + _i * 8192, _R, _C); \
        if (GATHER) { const int _r0 = _R, _r1 = HALF + _R; const int _id0 = _r0 < (u).nvalid ? (u).rows[_r0] : 0; const int _id1 = _r1 < (u).nvalid ? (u).rows[_r1] : 0; \
            v0[_i] = (unsigned)((_id0 >> 1) * K + _C) * 2u; v1[_i] = (unsigned)((_id1 >> 1) * K + _C) * 2u; } \
        else { v0[_i] = (unsigned)(_R * K + _C) * 2u; v1[_i] = v0[_i] + (unsigned)hstep; } } } while (0)
    GUnit cur, nxt; int ui = 0;
    if (!S.next(0, cur)) return;
    f32x4 acc[2][2][4][2];
#pragma unroll
    for (int a = 0; a < 2; ++a)
#pragma unroll
        for (int b = 0; b < 2; ++b)
#pragma unroll
            for (int m = 0; m < 4; ++m)
#pragma unroll
                for (int n = 0; n < 2; ++n) acc[a][b][m][n] = (f32x4){0.f, 0.f, 0.f, 0.f};
    bf16x8 At[4][2], B0[2][2], B1[2][2];
    unsigned cva0[2], cva1[2];
    const char* cA = cur.A; const char* cB = cur.B;
    PG8_MKVA(cur, cva0, cva1);
    PG8_STAGE(PG8_SB(0, 0), cB, voffB); PG8_STAGE(PG8_SB(0, 1), cB + hstep, voffB); PG8_STAGE(PG8_SA(0, 0), cA, cva0); PG8_STAGE(PG8_SA(0, 1), cA, cva1);
    if (wr == 1) PG8_BAR;
    PG8_WAIT_V(2); PG8_BAR;
    PG8_STAGE(PG8_SB(1, 0), cB + kstep, voffB); PG8_STAGE(PG8_SA(1, 0), cA + kstep, cva0); PG8_STAGE(PG8_SB(1, 1), cB + hstep + kstep, voffB);
    PG8_WAIT_V(6); PG8_BAR;
    for (;;) {
        const bool has_next = S.next(ui + 1, nxt);
        const char* nA = has_next ? nxt.A : cA; const char* nB = has_next ? nxt.B : cB;
        for (int t = 0; t < nt; t += 2) {
            const bool last = (t == nt - 2);
            const char* a1 = cA + (size_t)(t + 1) * kstep;
            const char* a2 = last ? nA : cA + (size_t)(t + 2) * kstep; const char* b2 = last ? nB : cB + (size_t)(t + 2) * kstep;
            const char* a3 = a2 + kstep; const char* b3 = b2 + kstep;
            PG8_LDB(B0, 0, 0); PG8_LDB(B1, 0, 1); PG8_SCHED; PG8_LDA(At, 0, 0); PG8_STAGE(PG8_SA(1, 1), a1, cva1);
            PG8_WAIT_V(8); PG8_WAIT_L(0); PG8_BAR; PG8_MMA(0, 0, At, B0); PG8_MMA(0, 1, At, B1); PG8_BAR; PG8_SCHED;
            if (GATHER) { if (last && has_next) PG8_MKVA(nxt, cva0, cva1); }
            PG8_LDA(At, 0, 1); PG8_STAGE(PG8_SB(0, 0), b2, voffB); PG8_STAGE(PG8_SB(0, 1), b2 + hstep, voffB); PG8_STAGE(PG8_SA(0, 0), a2, cva0);
            PG8_WAIT_V(8); PG8_WAIT_L(0); PG8_BAR; PG8_MMA(1, 0, At, B0); PG8_MMA(1, 1, At, B1); PG8_BAR; PG8_SCHED;
            PG8_LDB(B0, 1, 0); PG8_LDB(B1, 1, 1); PG8_SCHED; PG8_LDA(At, 1, 0); PG8_STAGE(PG8_SA(0, 1), a2, cva1);
            PG8_WAIT_V(8); PG8_WAIT_L(0); PG8_BAR; PG8_MMA(0, 0, At, B0); PG8_MMA(0, 1, At, B1); PG8_BAR; PG8_SCHED;
            PG8_LDA(At, 1, 1); PG8_STAGE(PG8_SB(1, 0), b3, voffB); PG8_STAGE(PG8_SB(1, 1), b3 + hstep, voffB); PG8_STAGE(PG8_SA(1, 0), a3, cva0);
            PG8_WAIT_V(8); PG8_WAIT_L(0); PG8_BAR; PG8_MMA(1, 0, At, B0); PG8_MMA(1, 1, At, B1); PG8_BAR; PG8_SCHED;
        }
        if constexpr (ALIGN_EPI) { if (wr == 0) PG8_BAR; }
        E(acc, cur, wr, wc, fr, fq);
        if (!has_next) break;
#pragma unroll
        for (int a = 0; a < 2; ++a)
#pragma unroll
            for (int b = 0; b < 2; ++b)
#pragma unroll
                for (int m = 0; m < 4; ++m)
#pragma unroll
                    for (int n = 0; n < 2; ++n) acc[a][b][m][n] = (f32x4){0.f, 0.f, 0.f, 0.f};
        cur = nxt; cA = nA; cB = nB; ++ui;
        if constexpr (ALIGN_EPI) { if (wr == 1) PG8_BAR; }
    }
    PG8_WAIT_V(0);
    if constexpr (!ALIGN_EPI) { if (wr == 0) PG8_BAR; }
    PG8_BAR;
#undef PG8_SA
#undef PG8_SB
#undef PG8_STAGE
#undef PG8_LDA
#undef PG8_LDB
#undef PG8_MMA
#undef PG8_WAIT_V
#undef PG8_WAIT_L
#undef PG8_BAR
#undef PG8_SCHED
#undef PG8_MKVA
}
}

struct Args { const float* in[25]; float* out; unsigned char* ws; };
struct Frame {
    LAS unsigned char* lds;
    unsigned* ctl;
    int tid, lane, wave, vcu, G;
    float* out; unsigned char* ws; unsigned char* dob;
};

using pg8::GUnit; using pg8::cvt_pk_bf16;
struct EpiProj {
    static constexpr bool PERM = true;
    bf16_t* proj; float* gates; bf16_t* halo;
    __device__ __forceinline__ void operator()(const f32x4 (&acc)[2][2][4][2], const GUnit& u, int wr, int wc, int fr, int fq) const {
        const int row0 = u.pm * 256 + wr * 64 + fr;
        if (u.pn < 14) {
            const int col0 = u.pn * 256 + wc * 32 + 8 * fq;
#pragma unroll
            for (int ai = 0; ai < 2; ++ai)
#pragma unroll
                for (int m = 0; m < 4; ++m) { bf16_t* rowp = proj + (size_t)(row0 + ai * 128 + m * 16) * NPROJ + col0;
#pragma unroll
                    for (int bj = 0; bj < 2; ++bj) { const f32x4 v0 = acc[ai][bj][m][0], v1 = acc[ai][bj][m][1];
                        u32x4 w; w.x = cvt_pk_bf16(v0[0], v0[1]); w.y = cvt_pk_bf16(v0[2], v0[3]); w.z = cvt_pk_bf16(v1[0], v1[1]); w.w = cvt_pk_bf16(v1[2], v1[3]);
                        *(u32x4*)(rowp + bj * 128) = w;
                        if (m == 3 && fr >= 13 && u.pn < 4) *(u32x4*)(halo + (size_t)((u.pm * 4 + ai * 2 + wr) * 3 + (fr - 13)) * 1024 + col0 + bj * 128) = w; } }
        } else if (wc == 0) {
#pragma unroll
            for (int ai = 0; ai < 2; ++ai)
#pragma unroll
                for (int m = 0; m < 4; ++m) { float* g = gates + (size_t)(row0 + ai * 128 + m * 16) * 32 + 8 * fq;
                    *(f32x4*)(g) = acc[ai][0][m][0]; *(f32x4*)(g + 4) = acc[ai][0][m][1]; }
        }
    }
};
struct EpiF32 {
    static constexpr bool PERM = false;
    float* C;
    __device__ __forceinline__ void operator()(const f32x4 (&acc)[2][2][4][2], const GUnit& u, int wr, int wc, int fr, int fq) const {
        const int row0 = u.pm * 256 + wr * 64 + fr, col0 = u.pn * 256 + wc * 32 + 4 * fq;
#pragma unroll
        for (int ai = 0; ai < 2; ++ai)
#pragma unroll
            for (int m = 0; m < 4; ++m) { float* rowp = C + (size_t)(row0 + ai * 128 + m * 16) * D + col0;
#pragma unroll
                for (int bj = 0; bj < 2; ++bj)
#pragma unroll
                    for (int n = 0; n < 2; ++n) *(f32x4*)(rowp + bj * 128 + n * 16) = acc[ai][bj][m][n]; }
    }
};
struct EpiHid {
    static constexpr bool PERM = true;
    bf16_t* hid;
    __device__ __forceinline__ void operator()(const f32x4 (&acc)[2][2][4][2], const GUnit& u, int wr, int wc, int fr, int fq) const {
        const int row0 = u.orow0 + wr * 64 + fr, col0 = u.pn * 128 + wc * 32 + 8 * fq;
#pragma unroll
        for (int ai = 0; ai < 2; ++ai)
#pragma unroll
            for (int m = 0; m < 4; ++m) { bf16_t* rowp = hid + (size_t)(row0 + ai * 128 + m * 16) * DEXP + col0;
                float h[8];
#pragma unroll
                for (int n = 0; n < 2; ++n)
#pragma unroll
                    for (int i = 0; i < 4; ++i) { const float g = acc[ai][0][m][n][i], up = acc[ai][1][m][n][i]; h[n * 4 + i] = siluf_(g) * up; }
                u32x4 w; w.x = cvt_pk_bf16(h[0], h[1]); w.y = cvt_pk_bf16(h[2], h[3]); w.z = cvt_pk_bf16(h[4], h[5]); w.w = cvt_pk_bf16(h[6], h[7]);
                *(u32x4*)(rowp) = w; }
    }
};
struct EpiY2 {
    static constexpr bool PERM = true;
    bf16_t* y2; const float* rtw;
    __device__ __forceinline__ void operator()(const f32x4 (&acc)[2][2][4][2], const GUnit& u, int wr, int wc, int fr, int fq) const {
        const int col0 = u.pn * 256 + wc * 32 + 8 * fq;
#pragma unroll
        for (int ai = 0; ai < 2; ++ai)
#pragma unroll
            for (int m = 0; m < 4; ++m) { const int r = ai * 128 + wr * 64 + m * 16 + fr;
                if (r < u.nvalid) { const int idx = u.rows[r]; const float wgt = rtw[idx]; bf16_t* rowp = y2 + (size_t)idx * D + col0;
#pragma unroll
                    for (int bj = 0; bj < 2; ++bj) { const f32x4 v0 = acc[ai][bj][m][0] * wgt, v1 = acc[ai][bj][m][1] * wgt;
                        u32x4 w; w.x = cvt_pk_bf16(v0[0], v0[1]); w.y = cvt_pk_bf16(v0[2], v0[3]); w.z = cvt_pk_bf16(v1[0], v1[1]); w.w = cvt_pk_bf16(v1[2], v1[3]);
                        *(u32x4*)(rowp + bj * 128) = w; } }
                asm volatile("" ::: "memory"); }
    }
};

template <class ColFn>
__device__ __forceinline__ void transpose_item(const float* W, int ldw, int K, bf16_t* WT, int k0, LAS float* scr, int lane, ColFn colfn) {
    const int col = colfn(4 * (lane & 7)); const int kr = lane >> 3;
    f32x4 v[8];
#pragma unroll
    for (int i = 0; i < 8; ++i) v[i] = col >= 0 ? *(const f32x4*)(W + (size_t)(k0 + kr + 8 * i) * ldw + col) : (f32x4){0.f, 0.f, 0.f, 0.f};
#pragma unroll
    for (int i = 0; i < 8; ++i) { LAS float* d = scr + (kr + 8 * i) * 33 + 4 * (lane & 7); d[0] = v[i][0]; d[1] = v[i][1]; d[2] = v[i][2]; d[3] = v[i][3]; }
    LDS_WAIT(); asm volatile("" ::: "memory");
    const int c = lane & 7;
#pragma unroll
    for (int j = 0; j < 4; ++j) { const int n = (lane >> 3) + 8 * j; const LAS float* s = scr + (8 * c) * 33 + n;
        u32x4 o; o.x = pk2(s[0 * 33], s[1 * 33]); o.y = pk2(s[2 * 33], s[3 * 33]); o.z = pk2(s[4 * 33], s[5 * 33]); o.w = pk2(s[6 * 33], s[7 * 33]);
        *(u32x4*)(WT + (size_t)n * K + k0 + 8 * c) = o; }
    LDS_WAIT(); asm volatile("" ::: "memory");
}
__device__ __forceinline__ int win_orig_col(int np) {
    if (np < 2048) return np;
    if (np < 3584) return np + 8;
    if (np < 3592) return 2048 + (np - 3584);
    if (np < 3608) return np;
    return -1;
}
__device__ __forceinline__ void p0_adaln_item(Frame& F, const Args& args, int it) {
    LAS float* cact = (LAS float*)F.lds;
    LAS float* red = cact + 8192;
    for (int i = F.tid; i < 8192; i += NT) cact[i] = siluf_(args.in[1][i]);
    __syncthreads();
    const int j = it * 64 + F.lane;
    float a[8];
#pragma unroll
    for (int b = 0; b < 8; ++b) a[b] = 0.f;
    const int kb = F.wave * 128;
#pragma unroll 32
    for (int k = kb; k < kb + 128; ++k) { const float w = args.in[2][(size_t)k * 6144 + j];
#pragma unroll
        for (int b = 0; b < 8; ++b) a[b] += cact[b * 1024 + k] * w; }
#pragma unroll
    for (int b = 0; b < 8; ++b) red[(F.wave * 8 + b) * 64 + F.lane] = a[b];
    __syncthreads();
    { const int b = F.tid >> 6, l = F.tid & 63; float s = 0.f;
#pragma unroll
      for (int w = 0; w < 8; ++w) s += red[(w * 8 + b) * 64 + l];
      float* mod = (float*)(F.ws + WS_MOD); mod[b * 6144 + it * 64 + l] = s + args.in[3][it * 64 + l]; }
    __syncthreads();
}
__device__ __forceinline__ void p0_prologue(Frame& F, const Args& args) {
    for (int it = blockIdx.x; it < 96; it += F.G) p0_adaln_item(F, args, it);
    LAS float* scr = (LAS float*)(F.lds + F.wave * 16384);
    const int gw = F.vcu * NWAVES + F.wave, NGW = F.G * NWAVES;
    constexpr int I_IN = (NPAD / 32) * 16, I_OUT = 32 * 16, I_GU = NEXP * 32 * 16, I_D = NEXP * 32 * 8;
    constexpr int NITEMS = I_IN + I_OUT + I_GU + I_D;
    bf16_t* WIN = (bf16_t*)(F.ws + WS_WIN); bf16_t* WOUT = (bf16_t*)(F.ws + WS_WOUT); bf16_t* WGU = (bf16_t*)(F.ws + WS_WGU); bf16_t* WD = (bf16_t*)(F.ws + WS_WD);
    for (int it = gw; it < NITEMS; it += NGW) {
        int r = it;
        if (r < I_IN) { const int nb = r >> 4, kb = r & 15; const int n0 = nb * 32;
            transpose_item(args.in[4], INW, D, WIN + (size_t)n0 * D, kb * 64, scr, F.lane, [n0](int n) { return win_orig_col(n0 + n); }); continue; }
        r -= I_IN;
        if (r < I_OUT) { const int nb = r >> 4, kb = r & 15; const int n0 = nb * 32;
            transpose_item(args.in[13], D, D, WOUT + (size_t)n0 * D, kb * 64, scr, F.lane, [n0](int n) { return n0 + n; }); continue; }
        r -= I_OUT;
        if (r < I_GU) { const int e = r >> 9, rr = r & 511, nb = rr >> 4, kb = rr & 15; const int row0 = nb * 32;
            const int pn = row0 >> 8, half = (row0 >> 7) & 1, j0 = row0 & 127; const int c0 = pn * 128 + j0;
            const float* src = (half ? args.in[21] : args.in[20]) + (size_t)e * D * DEXP;
            transpose_item(src, DEXP, D, WGU + ((size_t)e * 1024 + row0) * D, kb * 64, scr, F.lane, [c0](int n) { return c0 + n; }); continue; }
        r -= I_GU;
        { const int e = r >> 8, rr = r & 255, nb = rr >> 3, kb = rr & 7; const int n0 = nb * 32;
          const float* src = args.in[22] + (size_t)e * DEXP * D;
          transpose_item(src, D, DEXP, WD + ((size_t)e * 1024 + n0) * DEXP, kb * 64, scr, F.lane, [n0](int n) { return n0 + n; }); }
    }
    float* WRT = (float*)(F.ws + WS_WRT);
    for (int i = blockIdx.x * NT + F.tid; i < 36 * 1024; i += F.G * NT) { const int e = i >> 10, k = i & 1023; WRT[i] = e < 4 ? args.in[16][k * 4 + e] : args.in[18][k * 32 + (e - 4)]; }
}
__device__ __forceinline__ void p1_modulate(Frame& F, const Args& args) {
    const float* mod = (const float*)(F.ws + WS_MOD); bf16_t* U = (bf16_t*)(F.dob + DO_U);
    const int gw = F.vcu * NWAVES + F.wave, NGW = F.G * NWAVES;
    for (int t = gw; t < M; t += NGW) {
        const int b = t >> 11; const float* sh = mod + b * 6144; const float* sc = sh + 1024;
        const f32x4* xr = (const f32x4*)(args.in[0] + (size_t)t * D) + F.lane; u32x2* o = (u32x2*)(U + (size_t)t * D) + F.lane;
#pragma unroll
        for (int j = 0; j < 4; ++j) { const f32x4 v = xr[64 * j]; const f32x4 s = *((const f32x4*)sc + F.lane + 64 * j), h = *((const f32x4*)sh + F.lane + 64 * j);
            const f32x4 r = v * (s + 1.0f) + h; u32x2 w; w.x = pk2(r[0], r[1]); w.y = pk2(r[2], r[3]); o[64 * j] = w; }
    }
}

constexpr int TRS = 288;
typedef short s16x4 __attribute__((ext_vector_type(4)));
__device__ __forceinline__ bf16x8 cat4(s16x4 a, s16x4 b) { return __builtin_shufflevector(a, b, 0, 1, 2, 3, 4, 5, 6, 7); }
__device__ __forceinline__ void tr_frag2(unsigned tile, int ct, int lane, bf16x8& f0, bf16x8& f1) {
    const unsigned G = lane >> 4, q = (lane & 15) >> 2, p = lane & 3;
    const unsigned a = tile + (4 * G + q) * TRS + (16 * ct + 4 * p) * 2;
    s16x4 r0, r1, r2, r3;
    asm volatile("ds_read_b64_tr_b16 %0, %4\n\tds_read_b64_tr_b16 %1, %4 offset:4608\n\tds_read_b64_tr_b16 %2, %4 offset:9216\n\tds_read_b64_tr_b16 %3, %4 offset:13824\n\ts_waitcnt lgkmcnt(0)"
                 : "=&v"(r0), "=&v"(r1), "=&v"(r2), "=&v"(r3) : "v"(a) : "memory");
    f0 = cat4(r0, r1); f1 = cat4(r2, r3);
}
__device__ __forceinline__ void p3e_mlstm_item(Frame& F, const Args& args, int item) {
    const int c = item & 31, bh = item >> 5, b = bh >> 2, h = bh & 3, tid = F.tid, lane = F.lane;
    const int t0 = b * SEQ + c * 64;
    LAS unsigned char* vL = F.lds;
    LAS unsigned char* kL = F.lds + 64 * TRS;
    LAS float* wsL = (LAS float*)(F.lds + 2 * 64 * TRS);
    bf16_t* proj = (bf16_t*)(F.ws + WS_PROJ); const float* gates = (const float*)(F.ws + WS_GATES); const bf16_t* HALO = (const bf16_t*)(F.ws + WS_HALO);
    bf16_t* VT = (bf16_t*)(F.dob + DO_VTM) + (size_t)(bh * 32 + c) * 128 * 64; bf16_t* CT = (bf16_t*)(F.ws + WS_SM) + (size_t)(bh * 32 + c) * 128 * 128;
    const int t = tid >> 3, g8 = tid & 7, ch0 = g8 * 16;
#pragma unroll
    for (int q = 0; q < 2; ++q) { const int p = tid + 512 * q, r = p >> 4, c8 = (p & 15) * 8;
        *(LAS u32x4*)(vL + r * TRS + c8 * 2) = *(const u32x4*)(proj + (size_t)(t0 + r) * NPROJ + PC_MV + h * 128 + c8); }
    float aq[16], ak[16];
#pragma unroll
    for (int e = 0; e < 16; ++e) { aq[e] = args.in[6][h * 128 + ch0 + e]; ak[e] = args.in[6][512 + h * 128 + ch0 + e]; }
#pragma unroll
    for (int j = 0; j < 4; ++j) { const int r = t - 3 + j;
        if (r >= 0 || c > 0) {
            const bf16_t* rowq = r >= 0 ? proj + (size_t)(t0 + r) * NPROJ + PC_MQ + h * 128 + ch0 : HALO + (size_t)((b * 32 + c - 1) * 3 + 3 + r) * 1024 + h * 128 + ch0;
            const bf16_t* rowk = rowq + 512;
            const u32x4 q0 = ((const u32x4*)rowq)[0], q1 = ((const u32x4*)rowq)[1], k0 = ((const u32x4*)rowk)[0], k1 = ((const u32x4*)rowk)[1];
            const float* wq = args.in[5] + j * 1024 + h * 128 + ch0; const float* wk = wq + 512;
            const unsigned qw[8] = {q0.x, q0.y, q0.z, q0.w, q1.x, q1.y, q1.z, q1.w}, kw[8] = {k0.x, k0.y, k0.z, k0.w, k1.x, k1.y, k1.z, k1.w};
#pragma unroll
            for (int e = 0; e < 8; ++e) { aq[2 * e] += wq[2 * e] * bflo(qw[e]); aq[2 * e + 1] += wq[2 * e + 1] * bfhi(qw[e]); ak[2 * e] += wk[2 * e] * bflo(kw[e]); ak[2 * e + 1] += wk[2 * e + 1] * bfhi(kw[e]); } } }
#pragma unroll
    for (int e = 0; e < 16; ++e) { aq[e] = siluf_(aq[e]); ak[e] = siluf_(ak[e]) * 0.08838834764831845f; }
    if (tid < 64) {
        const float ig = gates[(size_t)(t0 + lane) * 32 + h] + args.in[7][h], lf = logsigf_(gates[(size_t)(t0 + lane) * 32 + 4 + h] + args.in[8][h]);
        const float bc = wave_scan_add(lf, lane), bL = __shfl(bc, 63);
        const float a = ig - bc, wl = bL - bc + ig, wmax = wave_max(wl), pm = wave_scan_max(a, lane);
        wsL[lane] = __expf(wl - wmax);
        const int gi = bh * SEQ + c * 64 + lane;
        ((float*)(F.ws + WS_GB))[gi] = bc; ((float*)(F.ws + WS_GA))[gi] = a; ((float*)(F.ws + WS_GPM))[gi] = pm;
        if (lane == 0) { ((float*)(F.ws + WS_BL))[bh * 32 + c] = bL; ((float*)(F.ws + WS_WM))[bh * 32 + c] = wmax; }
    }
    __syncthreads();
    { u32x4 o0, o1; o0.x = pk2(aq[0], aq[1]); o0.y = pk2(aq[2], aq[3]); o0.z = pk2(aq[4], aq[5]); o0.w = pk2(aq[6], aq[7]); o1.x = pk2(aq[8], aq[9]); o1.y = pk2(aq[10], aq[11]); o1.z = pk2(aq[12], aq[13]); o1.w = pk2(aq[14], aq[15]);
      u32x4* dq = (u32x4*)(proj + (size_t)(t0 + t) * NPROJ + PC_MQ + h * 128 + ch0); dq[0] = o0; dq[1] = o1;
      o0.x = pk2(ak[0], ak[1]); o0.y = pk2(ak[2], ak[3]); o0.z = pk2(ak[4], ak[5]); o0.w = pk2(ak[6], ak[7]); o1.x = pk2(ak[8], ak[9]); o1.y = pk2(ak[10], ak[11]); o1.z = pk2(ak[12], ak[13]); o1.w = pk2(ak[14], ak[15]);
      u32x4* dk = (u32x4*)(proj + (size_t)(t0 + t) * NPROJ + PC_MK + h * 128 + ch0); dk[0] = o0; dk[1] = o1;
      const float w = wsL[t];
      o0.x = pk2(ak[0] * w, ak[1] * w); o0.y = pk2(ak[2] * w, ak[3] * w); o0.z = pk2(ak[4] * w, ak[5] * w); o0.w = pk2(ak[6] * w, ak[7] * w);
      o1.x = pk2(ak[8] * w, ak[9] * w); o1.y = pk2(ak[10] * w, ak[11] * w); o1.z = pk2(ak[12] * w, ak[13] * w); o1.w = pk2(ak[14] * w, ak[15] * w);
      LAS u32x4* dl = (LAS u32x4*)(kL + t * TRS + ch0 * 2); dl[0] = o0; dl[1] = o1; }
    __syncthreads();
    if (tid < 128) { float a = 0.f;
#pragma unroll 8
        for (int s = 0; s < 64; ++s) a += bf2f(*(const LAS bf16_t*)(kL + s * TRS + tid * 2));
        ((float*)(F.ws + WS_NST))[(size_t)(bh * 32 + c) * 128 + tid] = a; }
    { const int w = F.wave, fr = lane & 15, g = lane >> 4;
      const unsigned vbase = (unsigned)(size_t)vL, kbase = (unsigned)(size_t)kL;
      bf16x8 vf0, vf1; tr_frag2(vbase, w, lane, vf0, vf1);
      *(bf16x8*)(VT + (size_t)(16 * w + fr) * 64 + 8 * g) = vf0; *(bf16x8*)(VT + (size_t)(16 * w + fr) * 64 + 32 + 8 * g) = vf1;
#pragma unroll 2
      for (int it = 0; it < 8; ++it) { bf16x8 kf0, kf1; tr_frag2(kbase, it, lane, kf0, kf1);
          f32x4 acc = (f32x4){0.f, 0.f, 0.f, 0.f};
          acc = __builtin_amdgcn_mfma_f32_16x16x32_bf16(kf0, vf0, acc, 0, 0, 0); acc = __builtin_amdgcn_mfma_f32_16x16x32_bf16(kf1, vf1, acc, 0, 0, 0);
          u32x2 o; o.x = pk2(acc[0], acc[1]); o.y = pk2(acc[2], acc[3]);
          *(u32x2*)(CT + (size_t)(16 * w + fr) * 128 + 16 * it + 4 * g) = o; } }
    __syncthreads();
}
__device__ __forceinline__ void p3e_gla_item(Frame& F, const Args& args, int item) {
    const int c = item & 31, bh = item >> 5, b = bh >> 2, h = bh & 3, tid = F.tid, lane = F.lane, w = F.wave;
    const int t0 = b * SEQ + c * 64;
    LAS unsigned char* vL = F.lds;
    LAS unsigned char* kL = F.lds + 64 * TRS;
    bf16_t* proj = (bf16_t*)(F.ws + WS_PROJ); const float* gates = (const float*)(F.ws + WS_GATES);
    bf16_t* VT = (bf16_t*)(F.dob + DO_VTG) + (size_t)(bh * 32 + c) * 128 * 64; bf16_t* ST = (bf16_t*)(F.ws + WS_SG) + (size_t)(bh * 32 + c) * 128 * 64;
#pragma unroll
    for (int q = 0; q < 2; ++q) { const int p = tid + 512 * q, r = p >> 4, c8 = (p & 15) * 8;
        *(LAS u32x4*)(vL + r * TRS + c8 * 2) = *(const u32x4*)(proj + (size_t)(t0 + r) * NPROJ + PC_GV + h * 128 + c8); }
    { const float* gr = gates + (size_t)(t0 + lane) * 32 + 8; const f32x4 g0 = *(const f32x4*)gr, g1 = *(const f32x4*)(gr + 4), g2 = *(const f32x4*)(gr + 8), g3 = *(const f32x4*)(gr + 12);
      const float ga[16] = {g0[0], g0[1], g0[2], g0[3], g1[0], g1[1], g1[2], g1[3], g2[0], g2[1], g2[2], g2[3], g3[0], g3[1], g3[2], g3[3]};
      bf16_t* qp = proj + (size_t)(t0 + lane) * NPROJ + PC_GQ + h * 64 + 8 * w; bf16_t* kp = proj + (size_t)(t0 + lane) * NPROJ + PC_GK + h * 64 + 8 * w;
      const u32x4 qw = *(const u32x4*)qp, kw = *(const u32x4*)kp;
      const float qv[8] = {bflo(qw.x), bfhi(qw.x), bflo(qw.y), bfhi(qw.y), bflo(qw.z), bfhi(qw.z), bflo(qw.w), bfhi(qw.w)};
      const float kv[8] = {bflo(kw.x), bfhi(kw.x), bflo(kw.y), bfhi(kw.y), bflo(kw.z), bfhi(kw.z), bflo(kw.w), bfhi(kw.w)};
      float qh[8], kh[8];
#pragma unroll
      for (int e = 0; e < 8; ++e) { const int ch = h * 64 + 8 * w + e; float acc = args.in[11][ch];
#pragma unroll
          for (int r = 0; r < 16; ++r) acc += ga[r] * args.in[10][r * 256 + ch];
          const float cum = wave_scan_add(logsigf_(acc) * 0.0625f, lane); const float ep = __expf(cum);
          qh[e] = qv[e] * 0.125f * ep; kh[e] = kv[e] * __expf(-cum);
          if (lane == 63) ((float*)(F.ws + WS_ECL))[(size_t)(bh * 32 + c) * 64 + 8 * w + e] = ep; }
      u32x4 oq, ok; oq.x = pk2(qh[0], qh[1]); oq.y = pk2(qh[2], qh[3]); oq.z = pk2(qh[4], qh[5]); oq.w = pk2(qh[6], qh[7]); ok.x = pk2(kh[0], kh[1]); ok.y = pk2(kh[2], kh[3]); ok.z = pk2(kh[4], kh[5]); ok.w = pk2(kh[6], kh[7]);
      *(u32x4*)qp = oq; *(u32x4*)kp = ok; *(LAS u32x4*)(kL + lane * TRS + 16 * w) = ok; }
    __syncthreads();
    { const int fr = lane & 15, g = lane >> 4;
      const unsigned vbase = (unsigned)(size_t)vL, kbase = (unsigned)(size_t)kL;
      bf16x8 vf0, vf1; tr_frag2(vbase, w, lane, vf0, vf1);
      *(bf16x8*)(VT + (size_t)(16 * w + fr) * 64 + 8 * g) = vf0; *(bf16x8*)(VT + (size_t)(16 * w + fr) * 64 + 32 + 8 * g) = vf1;
#pragma unroll 2
      for (int it = 0; it < 4; ++it) { bf16x8 kf0, kf1; tr_frag2(kbase, it, lane, kf0, kf1);
          f32x4 acc = (f32x4){0.f, 0.f, 0.f, 0.f};
          acc = __builtin_amdgcn_mfma_f32_16x16x32_bf16(kf0, vf0, acc, 0, 0, 0); acc = __builtin_amdgcn_mfma_f32_16x16x32_bf16(kf1, vf1, acc, 0, 0, 0);
          u32x2 o; o.x = pk2(acc[0], acc[1]); o.y = pk2(acc[2], acc[3]);
          *(u32x2*)(ST + (size_t)(16 * w + fr) * 64 + 16 * it + 4 * g) = o; } }
    __syncthreads();
}
__device__ __forceinline__ void p3e_chunks(Frame& F, const Args& args) {
    for (int it = F.vcu; it < 2048; it += F.G) { if (it < 1024) p3e_mlstm_item(F, args, it); else p3e_gla_item(F, args, it - 1024); }
}
__device__ __forceinline__ void p3s_scan(Frame& F, const Args& args) {
    LAS float* dL = (LAS float*)F.lds;
    LAS float* gL = dL + 32;
    const int tid = F.tid;
    for (int u = F.vcu; u < 768; u += F.G) {
        if (u < 512) {
            const int bh = u >> 4, part = u & 15;
            if (tid < 64) {
                const int lc = tid & 31;
                const float bl = ((const float*)(F.ws + WS_BL))[bh * 32 + lc], wm = ((const float*)(F.ws + WS_WM))[bh * 32 + lc];
                float m = 0.f, myd = 0.f, myg = 0.f, mym = 0.f;
#pragma unroll
                for (int c = 0; c < 32; ++c) { const float b_c = __shfl(bl, c), w_c = __shfl(wm, c); const float mn = fmaxf(b_c + m, w_c);
                    const float d = __expf(b_c + m - mn), g = __expf(w_c - mn); if (tid == c) { myd = d; myg = g; mym = m; } m = mn; }
                if (tid < 32) { dL[tid] = myd; gL[tid] = myg; if (part == 0) ((float*)(F.ws + WS_MST))[bh * 32 + tid] = mym; } }
            __syncthreads();
            { unsigned* p = (unsigned*)(F.ws + WS_SM) + (size_t)bh * 32 * 8192 + part * 512 + tid; float c0 = 0.f, c1 = 0.f;
              unsigned w[32];
#pragma unroll
              for (int c = 0; c < 32; ++c) w[c] = p[(size_t)c * 8192];
#pragma unroll
              for (int c = 0; c < 32; ++c) { p[(size_t)c * 8192] = pk2(c0, c1); const float d = dL[c], g = gL[c]; c0 = d * c0 + g * bflo(w[c]); c1 = d * c1 + g * bfhi(w[c]); } }
            if (part == 0 && tid < 128) { float* p = (float*)(F.ws + WS_NST) + (size_t)bh * 32 * 128 + tid; float n = 0.f;
#pragma unroll 8
                for (int c = 0; c < 32; ++c) { const float w = p[c * 128]; p[c * 128] = n; n = dL[c] * n + gL[c] * w; } }
            __syncthreads();
        } else {
            const int v = u - 512, bh = v >> 3, part = v & 7;
            unsigned* p = (unsigned*)(F.ws + WS_SG) + (size_t)bh * 32 * 4096 + part * 512 + tid; const int ch = (tid * 2) & 63;
            const float* ecl = (const float*)(F.ws + WS_ECL) + (size_t)bh * 32 * 64 + ch; float s0 = 0.f, s1 = 0.f;
            unsigned w[32]; f32x2 e[32];
#pragma unroll
            for (int c = 0; c < 32; ++c) { w[c] = p[(size_t)c * 4096]; e[c] = *(const f32x2*)(ecl + c * 64); }
#pragma unroll
            for (int c = 0; c < 32; ++c) { p[(size_t)c * 4096] = pk2(s0, s1); s0 = e[c][0] * (s0 + bflo(w[c])); s1 = e[c][1] * (s1 + bfhi(w[c])); }
        }
    }
}

template <bool ML>
__device__ __forceinline__ void p4_task(Frame& F, const Args& args, int item, int rt) {
    constexpr int DK = ML ? 128 : 64, KS = DK / 32;
    const int c = item & 31, bh = item >> 5, b = bh >> 2, h = bh & 3, lane = F.lane, fr = lane & 15, g = lane >> 4;
    const int t0 = b * SEQ + c * 64, trow = t0 + 16 * rt + fr, tl = 16 * rt + fr;
    const bf16_t* proj = (const bf16_t*)(F.ws + WS_PROJ);
    const int qcol = ML ? PC_MQ + h * 128 : PC_GQ + h * 64, kcol = ML ? PC_MK + h * 128 : PC_GK + h * 64;
    const bf16_t* CT = (const bf16_t*)(F.ws + (ML ? WS_SM : WS_SG)) + (size_t)(bh * 32 + c) * 128 * DK;
    const bf16_t* VT = (const bf16_t*)(F.dob + (ML ? DO_VTM : DO_VTG)) + (size_t)(bh * 32 + c) * 128 * 64;
    bf16_t* HC = (bf16_t*)(F.dob + DO_HCAT);
    bf16x8 qf[KS];
#pragma unroll
    for (int kk = 0; kk < KS; ++kk) qf[kk] = *(const bf16x8*)(proj + (size_t)trow * NPROJ + qcol + 32 * kk + 8 * g);
    f32x4 st[4];
#pragma unroll
    for (int a = 0; a < 4; ++a) { st[a] = (f32x4){0.f, 0.f, 0.f, 0.f};
        if (a <= rt) {
#pragma unroll
            for (int kk = 0; kk < KS; ++kk) { const bf16x8 kf = *(const bf16x8*)(proj + (size_t)(t0 + 16 * a + fr) * NPROJ + kcol + 32 * kk + 8 * g);
                st[a] = __builtin_amdgcn_mfma_f32_16x16x32_bf16(kf, qf[kk], st[a], 0, 0, 0); } } }
    float inter = 1.f, inv = 1.f;
    if (ML) {
        const float* GA = (const float*)(F.ws + WS_GA) + bh * SEQ + c * 64; const float* GB = (const float*)(F.ws + WS_GB) + bh * SEQ + c * 64; const float* GPM = (const float*)(F.ws + WS_GPM) + bh * SEQ + c * 64;
        const float mc = ((const float*)(F.ws + WS_MST))[bh * 32 + c];
        const float Mt = fmaxf(GPM[tl], mc), bt = GB[tl];
        float den = 0.f;
#pragma unroll
        for (int a = 0; a < 4; ++a) if (a <= rt) { const f32x4 av = *(const f32x4*)(GA + 16 * a + 4 * g);
#pragma unroll
            for (int r = 0; r < 4; ++r) { const int s = 16 * a + 4 * g + r; const float p = (s <= tl) ? st[a][r] * __expf(av[r] - Mt) : 0.f; st[a][r] = p; den += p; } }
        den += __shfl_xor(den, 16); den += __shfl_xor(den, 32);
        const float* NS = (const float*)(F.ws + WS_NST) + (size_t)(bh * 32 + c) * 128;
        float qn = 0.f;
#pragma unroll
        for (int kk = 0; kk < KS; ++kk) { const f32x4 n0 = *(const f32x4*)(NS + 32 * kk + 8 * g), n1 = *(const f32x4*)(NS + 32 * kk + 8 * g + 4);
            const u32x4 w = __builtin_bit_cast(u32x4, qf[kk]);
            qn += bflo(w.x) * n0[0] + bfhi(w.x) * n0[1] + bflo(w.y) * n0[2] + bfhi(w.y) * n0[3] + bflo(w.z) * n1[0] + bfhi(w.z) * n1[1] + bflo(w.w) * n1[2] + bfhi(w.w) * n1[3]; }
        qn += __shfl_xor(qn, 16); qn += __shfl_xor(qn, 32);
        inter = __expf(mc - Mt);
        den += inter * qn;
        inv = 1.0f / fmaxf(fabsf(den), __expf(-(bt + Mt)));
    } else {
#pragma unroll
        for (int a = 0; a < 4; ++a)
#pragma unroll
            for (int r = 0; r < 4; ++r) { const int s = 16 * a + 4 * g + r; if (s > tl) st[a][r] = 0.f; }
    }
    bf16x8 pf[2];
#pragma unroll
    for (int k2 = 0; k2 < 2; ++k2) { u32x4 w; w.x = pg8::cvt_pk_bf16(st[2 * k2][0], st[2 * k2][1]); w.y = pg8::cvt_pk_bf16(st[2 * k2][2], st[2 * k2][3]);
        w.z = pg8::cvt_pk_bf16(st[2 * k2 + 1][0], st[2 * k2 + 1][1]); w.w = pg8::cvt_pk_bf16(st[2 * k2 + 1][2], st[2 * k2 + 1][3]); pf[k2] = __builtin_bit_cast(bf16x8, w); }
    f32x4 o[8];
#pragma unroll
    for (int n = 0; n < 8; ++n) { f32x4 acc = (f32x4){0.f, 0.f, 0.f, 0.f};
#pragma unroll
        for (int kk = 0; kk < KS; ++kk) { const bf16x8 cf = *(const bf16x8*)(CT + (size_t)(16 * n + fr) * DK + 32 * kk + 8 * g); acc = __builtin_amdgcn_mfma_f32_16x16x32_bf16(cf, qf[kk], acc, 0, 0, 0); }
        if (ML) acc = acc * inter;
#pragma unroll
        for (int k2 = 0; k2 < 2; ++k2) if (2 * k2 <= rt) { const bf16x8 vf = *(const bf16x8*)(VT + (size_t)(16 * n + fr) * 64 + 32 * k2 + 8 * g); acc = __builtin_amdgcn_mfma_f32_16x16x32_bf16(vf, pf[k2], acc, 0, 0, 0); }
        o[n] = acc; }
    float ss = 0.f;
#pragma unroll
    for (int n = 0; n < 8; ++n) { const int col = h * 128 + 16 * n + 4 * g;
        if (ML) { const u32x2 w = *(const u32x2*)(proj + (size_t)trow * NPROJ + PC_MO + col);
            o[n][0] *= inv * sigmoidf_(bflo(w.x)); o[n][1] *= inv * sigmoidf_(bfhi(w.x)); o[n][2] *= inv * sigmoidf_(bflo(w.y)); o[n][3] *= inv * sigmoidf_(bfhi(w.y)); }
        ss += (o[n][0] * o[n][0] + o[n][1] * o[n][1]) + (o[n][2] * o[n][2] + o[n][3] * o[n][3]); }
    ss += __shfl_xor(ss, 16); ss += __shfl_xor(ss, 32);
    const float rstd = 1.0f / sqrtf(ss * (1.0f / 128.0f) + LN_EPS);
#pragma unroll
    for (int n = 0; n < 8; ++n) { const int col = h * 128 + 16 * n + 4 * g; const f32x4 gm = *(const f32x4*)((ML ? args.in[9] : args.in[12]) + col);
        f32x4 r = o[n] * rstd * gm;
        if (!ML) { const u32x2 w = *(const u32x2*)(proj + (size_t)trow * NPROJ + PC_GG + col); r[0] *= siluf_(bflo(w.x)); r[1] *= siluf_(bfhi(w.x)); r[2] *= siluf_(bflo(w.y)); r[3] *= siluf_(bfhi(w.y)); }
        u32x2 ov; ov.x = pk2(r[0], r[1]); ov.y = pk2(r[2], r[3]);
        *(u32x2*)(HC + (size_t)trow * D + (ML ? 0 : 512) + col) = ov; }
}
__device__ __forceinline__ void p4_chunks(Frame& F, const Args& args) {
    const int gw = F.vcu * NWAVES + F.wave, NGW = F.G * NWAVES;
    for (int w = gw; w < 8192; w += NGW) { const int item = w >> 2, rt = w & 3; if (item < 1024) p4_task<true>(F, args, item, rt); else p4_task<false>(F, args, item - 1024, rt); }
}

__device__ __forceinline__ void p5b_ln_route(Frame& F, const Args& args) {
    LAS float* WL = (LAS float*)F.lds;
    LAS int* lcnt = (LAS int*)(F.lds + LDSCTL_OFF + 2560);
    LAS int* lbase = lcnt + 32;
    LAS int* rec_e = lbase + 32;
    LAS int* rec_rank = rec_e + 128;
    LAS int* rec_idx = rec_rank + 128;
    LAS float* rec_w = (LAS float*)(rec_idx + 128);
    const float* mod = (const float*)(F.ws + WS_MOD); const float* WRT = (const float*)(F.ws + WS_WRT);
    float* Y = (float*)(F.ws + WS_Y); bf16_t* U2 = (bf16_t*)(F.ws + WS_U2);
    int* list = (int*)(F.ws + WS_LIST); float* rtw = (float*)(F.ws + WS_RTW);
    const int lane = F.lane, tid = F.tid;
    for (int i = tid; i < 36 * 256; i += NT) *(LAS f32x4*)(WL + 4 * i) = *(const f32x4*)(WRT + 4 * i);
    for (int rb = F.vcu; rb < M / 64; rb += F.G) {
        if (tid < 32) lcnt[tid] = 0;
        __syncthreads();
        for (int q = 0; q < 4; ++q) {
            const int lr0 = F.wave * 8 + 2 * q, tA = rb * 64 + lr0, b = tA >> 11;
            const float* mb = mod + b * 6144;
            f32x4 u2[2][4];
#pragma unroll
            for (int rr = 0; rr < 2; ++rr) { const int t = tA + rr;
                f32x4 z[4]; float s = 0.f;
#pragma unroll
                for (int j = 0; j < 4; ++j) { const int k = 4 * lane + 256 * j; const f32x4 xv = *(const f32x4*)(args.in[0] + (size_t)t * D + k), yv = *(const f32x4*)(Y + (size_t)t * D + k), g1 = *(const f32x4*)(mb + 2048 + k);
                    z[j] = xv * DN_ALPHA + (g1 + 1.0f) * yv; s += (z[j][0] + z[j][1]) + (z[j][2] + z[j][3]); }
                const float mean = wave_sum(s) * (1.0f / D); float s2 = 0.f;
#pragma unroll
                for (int j = 0; j < 4; ++j) { z[j] = z[j] - mean; s2 += (z[j][0] * z[j][0] + z[j][1] * z[j][1]) + (z[j][2] * z[j][2] + z[j][3] * z[j][3]); }
                const float rstd = 1.0f / sqrtf(wave_sum(s2) * (1.0f / D) + LN_EPS);
#pragma unroll
                for (int j = 0; j < 4; ++j) { const int k = 4 * lane + 256 * j; const f32x4 lg = *(const f32x4*)(args.in[14] + k), lb = *(const f32x4*)(args.in[15] + k);
                    const f32x4 x1 = z[j] * rstd * lg + lb; *(f32x4*)(Y + (size_t)t * D + k) = x1;
                    const f32x4 sc2 = *(const f32x4*)(mb + 4096 + k), sh2 = *(const f32x4*)(mb + 3072 + k);
                    u2[rr][j] = x1 * (sc2 + 1.0f) + sh2; u32x2 w; w.x = pk2(u2[rr][j][0], u2[rr][j][1]); w.y = pk2(u2[rr][j][2], u2[rr][j][3]); *(u32x2*)(U2 + (size_t)t * D + k) = w; } }
            float lgA = 0.f, lgB = 0.f;
#pragma unroll 2
            for (int e = 0; e < 36; ++e) { float pa = 0.f, pb = 0.f;
#pragma unroll
                for (int j = 0; j < 4; ++j) { const f32x4 w = *(const LAS f32x4*)(WL + e * 1024 + 4 * lane + 256 * j);
                    pa += (u2[0][j][0] * w[0] + u2[0][j][1] * w[1]) + (u2[0][j][2] * w[2] + u2[0][j][3] * w[3]);
                    pb += (u2[1][j][0] * w[0] + u2[1][j][1] * w[1]) + (u2[1][j][2] * w[2] + u2[1][j][3] * w[3]); }
                pa = wave_sum(pa); pb = wave_sum(pb);
                if (lane == e) { lgA = pa; lgB = pb; } }
            { const float bias = lane < 4 ? args.in[17][lane] : (lane < 36 ? args.in[19][lane - 4] : 0.f); lgA += bias; lgB += bias; }
#pragma unroll
            for (int rr = 0; rr < 2; ++rr) { const float mylogit = rr ? lgB : lgA; const int lr = lr0 + rr, t = tA + rr;
                float lg4[4];
#pragma unroll
                for (int i = 0; i < 4; ++i) lg4[i] = rdlane(mylogit, i);
                int gs = 0; float gm = lg4[0];
#pragma unroll
                for (int i = 1; i < 4; ++i) if (lg4[i] > gm) { gm = lg4[i]; gs = i; }
                float gsum = 0.f;
#pragma unroll
                for (int i = 0; i < 4; ++i) gsum += __expf(lg4[i] - gm);
                const float pg = 1.0f / gsum;
                float ein[8];
#pragma unroll
                for (int i = 0; i < 8; ++i) ein[i] = __shfl(mylogit, 4 + gs * 8 + i);
                int i1 = 0; float v1 = ein[0];
#pragma unroll
                for (int i = 1; i < 8; ++i) if (ein[i] > v1) { v1 = ein[i]; i1 = i; }
                int i2 = -1; float v2 = -3.0e38f;
#pragma unroll
                for (int i = 0; i < 8; ++i) if (i != i1 && ein[i] > v2) { v2 = ein[i]; i2 = i; }
                const float ex = __expf(v2 - v1); const float p1 = 1.0f / (1.0f + ex), p2 = ex * p1;
                if (lane == 0) {
                    const int e1 = gs * 8 + i1, e2 = gs * 8 + i2;
                    const int r1 = atomicAdd((int*)&lcnt[e1], 1), r2 = atomicAdd((int*)&lcnt[e2], 1);
                    rec_e[lr * 2] = e1; rec_rank[lr * 2] = r1; rec_idx[lr * 2] = t * 2; rec_w[lr * 2] = pg * p1;
                    rec_e[lr * 2 + 1] = e2; rec_rank[lr * 2 + 1] = r2; rec_idx[lr * 2 + 1] = t * 2 + 1; rec_w[lr * 2 + 1] = pg * p2;
                } }
        }
        __syncthreads();
        if (tid < 32) { const int n = lcnt[tid]; lbase[tid] = n ? (int)__hip_atomic_fetch_add(F.ctl + CW_ECNT + 64 * tid, (unsigned)n, RLX_AGENT) : 0; }
        __syncthreads();
        if (tid < 128) { const int e = rec_e[tid], pos = lbase[e] + rec_rank[tid], idx = rec_idx[tid]; list[(size_t)e * LISTCAP + pos] = idx; rtw[idx] = rec_w[tid]; }
        __syncthreads();
    }
}
__device__ __forceinline__ void moe_tables(Frame& F) {
    LAS int* tab = (LAS int*)(F.lds + MOE_OFF);
    if (F.tid < 32) tab[66 + F.tid] = (int)__hip_atomic_load(F.ctl + CW_ECNT + 64 * F.tid, RLX_AGENT);
    __syncthreads();
    if (F.tid == 0) { int ts = 0, hr = 0; for (int e = 0; e < 32; ++e) { tab[e] = ts; tab[33 + e] = hr; const int nt = (tab[66 + e] + 255) >> 8; ts += nt; hr += nt * 256; } tab[32] = ts; tab[65] = hr; }
    __syncthreads();
}
__device__ __forceinline__ void p7_final(Frame& F, const Args& args) {
    const float* mod = (const float*)(F.ws + WS_MOD); const float* X1 = (const float*)(F.ws + WS_Y); const bf16_t* Y2 = (const bf16_t*)(F.dob + DO_Y2);
    const int gw = F.vcu * NWAVES + F.wave, NGW = F.G * NWAVES, lane = F.lane;
    for (int t = gw; t < M; t += NGW) {
        const int b = t >> 11; const float* mb = mod + b * 6144;
        f32x4 z[4]; float s = 0.f;
#pragma unroll
        for (int j = 0; j < 4; ++j) { const int k = 4 * lane + 256 * j; const f32x4 xv = *(const f32x4*)(X1 + (size_t)t * D + k), g2 = *(const f32x4*)(mb + 5120 + k);
            const u32x2 wa = *(const u32x2*)(Y2 + (size_t)(2 * t) * D + k), wb = *(const u32x2*)(Y2 + (size_t)(2 * t + 1) * D + k);
            const f32x4 yv = (f32x4){bflo(wa.x) + bflo(wb.x), bfhi(wa.x) + bfhi(wb.x), bflo(wa.y) + bflo(wb.y), bfhi(wa.y) + bfhi(wb.y)};
            z[j] = xv * DN_ALPHA + (g2 + 1.0f) * yv; s += (z[j][0] + z[j][1]) + (z[j][2] + z[j][3]); }
        const float mean = wave_sum(s) * (1.0f / D); float s2 = 0.f;
#pragma unroll
        for (int j = 0; j < 4; ++j) { z[j] = z[j] - mean; s2 += (z[j][0] * z[j][0] + z[j][1] * z[j][1]) + (z[j][2] * z[j][2] + z[j][3] * z[j][3]); }
        const float rstd = 1.0f / sqrtf(wave_sum(s2) * (1.0f / D) + LN_EPS);
#pragma unroll
        for (int j = 0; j < 4; ++j) { const int k = 4 * lane + 256 * j; const f32x4 lg = *(const f32x4*)(args.in[23] + k), lb = *(const f32x4*)(args.in[24] + k);
            *(f32x4*)(F.out + (size_t)t * D + k) = z[j] * rstd * lg + lb; }
    }
}

__global__ void __launch_bounds__(NT, 2) mega_fwd(Args args) {
    extern __shared__ __attribute__((aligned(16))) unsigned char lds_raw[];
    Frame F;
    F.lds = (LAS unsigned char*)lds_raw;
    F.tid = threadIdx.x; F.lane = F.tid & 63; F.wave = __builtin_amdgcn_readfirstlane(F.tid >> 6);
    F.G = gridDim.x; { const int bx = blockIdx.x; F.vcu = (F.G % 8 == 0) ? (bx % 8) * (F.G / 8) + bx / 8 : bx; }
    F.ws = args.ws; F.ctl = (unsigned*)(args.ws + WS_CTL); F.out = args.out; F.dob = (unsigned char*)args.out;
    for (int u = F.tid; u < (LDS_BYTES - LDSCTL_OFF) / 4; u += NT) ((LAS unsigned*)(F.lds + LDSCTL_OFF))[u] = 0u;
    __syncthreads();
    XcdBarrier bar = xcd_barrier_post(F.ctl + CW_BAR, (volatile LAS unsigned*)(F.lds + MISC_OFF) + 8);
#ifndef PROBE_TS
#define PROBE_TS 0
#endif
    LAS unsigned long long* tsL = (LAS unsigned long long*)(F.lds + LDSCTL_OFF + 2048);
    LAS unsigned* tsN = (LAS unsigned*)(F.lds + LDSCTL_OFF + 2048 + 256);
#define STAMP() do { if (PROBE_TS && blockIdx.x == 0 && threadIdx.x == 0) { const unsigned k_ = *tsN; tsL[k_] = __builtin_amdgcn_s_memrealtime(); *tsN = k_ + 1; } } while (0)
#define GRID_BAR() do { xcd_barrier(bar); STAMP(); } while (0)
    STAMP();
#ifndef RPT_MASK
#define RPT_MASK 0
#endif
#define NREP(k) ((((RPT_MASK) >> (k)) & 1) + 1)
#define PHASE_ENTER() do { F.tid = threadIdx.x; asm volatile("" : "+s"(F.ws), "+s"(F.dob), "+s"(F.ctl), "+v"(F.tid), "+s"(F.vcu), "+s"(F.G)); F.lane = F.tid & 63; } while (0)
    for (int rep = 0; rep < NREP(0); ++rep) { PHASE_ENTER(); p0_prologue(F, args); GRID_BAR(); }
    for (int rep = 0; rep < NREP(1); ++rep) { PHASE_ENTER(); p1_modulate(F, args); GRID_BAR(); }
#define RUN_P2() do { PHASE_ENTER(); \
      { pg8::DenseSched S; S.init(F.dob + DO_U, F.ws + WS_WIN, M, NPAD, D, F.G, (int)blockIdx.x); \
        EpiProj E{(bf16_t*)(F.ws + WS_PROJ), (float*)(F.ws + WS_GATES), (bf16_t*)(F.ws + WS_HALO)}; \
        pg8::gemm_phase<false, true>(F.lds, D, S, E); } \
      GRID_BAR(); } while (0)
#define RUN_E() do { PHASE_ENTER(); p3e_chunks(F, args); GRID_BAR(); } while (0)
#define RUN_S() do { PHASE_ENTER(); p3s_scan(F, args); GRID_BAR(); } while (0)
#ifndef PROBE_REP
#define PROBE_REP 0
#endif
    for (int rep = 0; rep < NREP(2); ++rep) RUN_P2();
    RUN_E();
#if PROBE_REP == 1
    { PHASE_ENTER(); p1_modulate(F, args); GRID_BAR(); } RUN_P2(); RUN_E();
#endif
    RUN_S();
#if PROBE_REP == 2
    { PHASE_ENTER(); p1_modulate(F, args); GRID_BAR(); } RUN_P2(); RUN_E(); RUN_S();
#endif
    for (int rep = 0; rep < NREP(4); ++rep) { PHASE_ENTER(); p4_chunks(F, args); GRID_BAR(); }
    for (int rep = 0; rep < NREP(5); ++rep) {
      PHASE_ENTER();
      { pg8::DenseSched S; S.init(F.dob + DO_HCAT, F.ws + WS_WOUT, M, D, D, F.G, (int)blockIdx.x);
        EpiF32 E{(float*)(F.ws + WS_Y)};
        pg8::gemm_phase<false, true>(F.lds, D, S, E); }
      GRID_BAR(); }
    PHASE_ENTER();
    p5b_ln_route(F, args);
    GRID_BAR();
    PHASE_ENTER();
    moe_tables(F);
    for (int rep = 0; rep < NREP(6); ++rep) {
      PHASE_ENTER();
      { pg8::MoeSched S{(const char*)(F.ws + WS_U2), (const char*)(F.ws + WS_WGU), (size_t)1024 * 1024 * 2, D, (const LAS int*)(F.lds + MOE_OFF), (const int*)(F.ws + WS_LIST), F.G, (int)blockIdx.x, true};
        EpiHid E{(bf16_t*)(F.ws + WS_HID)};
        pg8::gemm_phase<true, true>(F.lds, D, S, E); }
      GRID_BAR(); }
    for (int rep = 0; rep < NREP(7); ++rep) {
      PHASE_ENTER();
      { pg8::MoeSched S{(const char*)(F.ws + WS_HID), (const char*)(F.ws + WS_WD), (size_t)1024 * 512 * 2, DEXP, (const LAS int*)(F.lds + MOE_OFF), (const int*)(F.ws + WS_LIST), F.G, (int)blockIdx.x, false};
        EpiY2 E{(bf16_t*)(F.dob + DO_Y2), (const float*)(F.ws + WS_RTW)};
        pg8::gemm_phase<false, true>(F.lds, DEXP, S, E); }
      GRID_BAR(); }
    PHASE_ENTER();
    p7_final(F, args);
#if PROBE_TS
    GRID_BAR();
    if (blockIdx.x == 0 && threadIdx.x == 0) { const int pa = PROBE_TS & 15; const float ta = (float)(tsL[pa + 1] - tsL[pa]) * 0.01f;
        __hip_atomic_store((float*)(F.ctl + CW_DBG), ta, RLX_AGENT); }
    GRID_BAR();
    { const float ta = __hip_atomic_load((float*)(F.ctl + CW_DBG), RLX_AGENT); const float dlt = ta * (1.0f / (float)(PROBE_TS >> 8));
      const int gw = F.vcu * NWAVES + (threadIdx.x >> 6), NGW = F.G * NWAVES, ln = threadIdx.x & 63;
      for (int t = gw; t < M; t += NGW) { f32x4* o = (f32x4*)(F.out + (size_t)t * D) + ln;
#pragma unroll
          for (int j = 0; j < 4; ++j) { f32x4 v = o[64 * j]; v = v + dlt; o[64 * j] = v; } } }
#endif
}

extern "C" void kernel_launch(void* const* d_in, const int* in_sizes, int n_in, void* d_out, int out_size, void* d_ws, size_t ws_size, hipStream_t stream) {
    static int grid = 0;
    if (grid == 0) {
        if (n_in != 25 || out_size != M * D || ws_size < WS_END) { fprintf(stderr, "kernel_launch: unexpected problem (n_in %d out %d ws %zu)\n", n_in, out_size, ws_size); grid = -1; return; }
        int dev = 0, cus = 0;
        if (hipGetDevice(&dev) != hipSuccess || hipDeviceGetAttribute(&cus, hipDeviceAttributeMultiprocessorCount, dev) != hipSuccess) { grid = -1; return; }
        if (hipFuncSetAttribute((const void*)mega_fwd, hipFuncAttributeMaxDynamicSharedMemorySize, LDS_BYTES) != hipSuccess) { fprintf(stderr, "kernel_launch: hipFuncSetAttribute failed\n"); grid = -1; return; }
        int per_cu = 0;
        (void)hipOccupancyMaxActiveBlocksPerMultiprocessor(&per_cu, (const void*)mega_fwd, NT, LDS_BYTES);
        (void)hipGetLastError();
        if (per_cu < 1) fprintf(stderr, "kernel_launch: occupancy query says %d\n", per_cu);
        grid = cus;
    }
    if (grid < 0) return;
    (void)hipMemsetAsync((char*)d_ws + WS_CTL, 0, CTL_ZERO_BYTES, stream);
    Args a{};
    for (int i = 0; i < 25; ++i) a.in[i] = (const float*)d_in[i];
    a.out = (float*)d_out; a.ws = (unsigned char*)d_ws;
    hipLaunchKernelGGL(mega_fwd, dim3(grid), dim3(NT), LDS_BYTES, stream, a);
}
```
